# Optimizing an MI355X kernel written in HIP

```python
import jax, jax.numpy as jnp
from jax import lax
import numpy as np

D_MODEL = 2048
BATCH = 2
SEQ = 4096
DEPTH = 2

HEAD_DIM = 128
MOBA_HEADS = 8
MOBA_BLOCK = 256
MOBA_TOPK = 3
MOBA_Q_CHUNK = 32
ROPE_THETA = 10000.0
RET_HEADS = 8
RET_QK_DIM = 128
RET_V_DIM = 256
RET_CHUNK = 128
D_FF = 256 * ((8 * D_MODEL // 3 + 255) // 256)
NORM_EPS = 1e-6
NEG_INF = -1e30

MOBA_W = MOBA_HEADS * HEAD_DIM
RET_QK_W = RET_HEADS * RET_QK_DIM
RET_V_W = RET_HEADS * RET_V_DIM
IN_SPLITS = (MOBA_W, MOBA_W, MOBA_W, RET_QK_W, RET_QK_W, RET_V_W, RET_V_W, D_MODEL, D_MODEL)
IN_WIDTH = MOBA_W * 3 + RET_QK_W * 2 + RET_V_W * 2 + D_MODEL * 2

kernel_name = "hybrid_moba_retention_macaron"


def rms_norm(x, g):
    xf = x.astype(jnp.float32)
    y = xf * lax.rsqrt(jnp.mean(xf * xf, axis=-1, keepdims=True) + NORM_EPS)
    return (y * g.astype(jnp.float32)).astype(x.dtype)


def swiglu(x, w_gate, w_up, w_down):
    return (jax.nn.silu(x @ w_gate) * (x @ w_up)) @ w_down


def rope_tables(seq, inv_freq, dtype):
    ang = jnp.arange(seq, dtype=jnp.float32)[:, None] * inv_freq[None, :]
    return jnp.cos(ang).astype(dtype), jnp.sin(ang).astype(dtype)


def apply_rotary(x, cos, sin):
    x1, x2 = jnp.split(x, 2, axis=-1)
    c = cos[None, :, None, :]
    s = sin[None, :, None, :]
    return jnp.concatenate([x1 * c - x2 * s, x1 * s + x2 * c], axis=-1)


def moba_attention(q, k, v):
    b, s, h, d = q.shape
    scale = d ** -0.5
    nb = -(-s // MOBA_BLOCK)
    pad = nb * MOBA_BLOCK - s
    n_sel = min(MOBA_TOPK, nb)
    q = q.transpose(0, 2, 1, 3)
    padw = ((0, 0), (0, 0), (0, pad), (0, 0))
    k = jnp.pad(k.transpose(0, 2, 1, 3), padw)
    v = jnp.pad(v.transpose(0, 2, 1, 3), padw)
    k_blocks = k.reshape(b, h, nb, MOBA_BLOCK, d)
    v_blocks = v.reshape(b, h, nb, MOBA_BLOCK, d)
    k_mean = jnp.mean(k_blocks.astype(jnp.float32), axis=3)
    gather = jax.vmap(jax.vmap(lambda blocks, idx: blocks[idx]))
    blk_ids = jnp.arange(nb)
    slot_ids = jnp.arange(n_sel)
    q_offs = jnp.arange(MOBA_Q_CHUNK)
    k_offs = jnp.arange(MOBA_BLOCK)

    def chunk(c):
        start = c * MOBA_Q_CHUNK
        blk = start // MOBA_BLOCK
        qc = lax.dynamic_slice_in_dim(q, start, MOBA_Q_CHUNK, axis=2)
        gate = jnp.einsum('bhqd,bhnd->bhqn', qc.astype(jnp.float32), k_mean)
        gate = jnp.where(blk_ids < blk, gate, -jnp.inf)
        _, idx = lax.top_k(gate, n_sel)
        k_sel = gather(k_blocks, idx)
        v_sel = gather(v_blocks, idx)
        s_sel = jnp.einsum('bhqd,bhqtkd->bhqtk', qc, k_sel).astype(jnp.float32) * scale
        s_sel = jnp.where((slot_ids < blk)[:, None], s_sel, NEG_INF)
        k_own = lax.dynamic_index_in_dim(k_blocks, blk, axis=2, keepdims=False)
        v_own = lax.dynamic_index_in_dim(v_blocks, blk, axis=2, keepdims=False)
        s_own = jnp.einsum('bhqd,bhkd->bhqk', qc, k_own).astype(jnp.float32) * scale
        causal = (blk * MOBA_BLOCK + k_offs)[None, :] <= (start + q_offs)[:, None]
        s_own = jnp.where(causal, s_own, NEG_INF)
        scores = jnp.concatenate([s_sel.reshape(b, h, MOBA_Q_CHUNK, n_sel * MOBA_BLOCK), s_own], axis=-1)
        p = jax.nn.softmax(scores, axis=-1).astype(v.dtype)
        p_sel = p[..., :n_sel * MOBA_BLOCK].reshape(b, h, MOBA_Q_CHUNK, n_sel, MOBA_BLOCK)
        p_own = p[..., n_sel * MOBA_BLOCK:]
        return (jnp.einsum('bhqtk,bhqtkd->bhqd', p_sel, v_sel)
                + jnp.einsum('bhqk,bhkd->bhqd', p_own, v_own))

    out = lax.map(chunk, jnp.arange(s // MOBA_Q_CHUNK))
    return out.transpose(1, 0, 3, 2, 4).reshape(b, s, h * d)


def retention(q, k, v):
    b, s, h, dk = q.shape
    dv = v.shape[-1]
    n = s // RET_CHUNK
    dt = q.dtype

    def chunked(t):
        return t.reshape(b, n, RET_CHUNK, h, t.shape[-1]).transpose(0, 3, 1, 2, 4)

    q = chunked(q)
    k = chunked(k * (dk ** -0.5))
    v = chunked(v)
    log_g = jnp.log1p(-jnp.exp2(-5.0 - jnp.arange(h, dtype=jnp.float32)))
    pos = jnp.arange(RET_CHUNK, dtype=jnp.float32)
    diff = pos[:, None] - pos[None, :]
    inner_decay = jnp.where(diff >= 0, jnp.exp(jnp.maximum(diff, 0.0)[None] * log_g[:, None, None]), 0.0)
    zeta = jnp.exp((RET_CHUNK - 1 - pos)[None, :] * log_g[:, None])
    xi = jnp.exp((pos + 1)[None, :] * log_g[:, None])
    chunk_decay = jnp.exp(RET_CHUNK * log_g)

    scores = jnp.einsum('bhncd,bhnmd->bhncm', q, k) * inner_decay[:, None].astype(dt)
    inner = jnp.einsum('bhncm,bhnme->bhnce', scores, v)
    kv = jnp.einsum('bhncd,bhnce->bhnde', k * zeta[:, None, :, None].astype(dt), v)
    decay_b = chunk_decay[None, :, None, None].astype(dt)

    def step(state, kv_n):
        return decay_b * state + kv_n, state

    _, prev = lax.scan(step, jnp.zeros((b, h, dk, dv), dt), jnp.moveaxis(kv, 2, 0))
    prev = jnp.moveaxis(prev, 0, 2)
    cross = jnp.einsum('bhncd,bhnde->bhnce', q, prev) * xi[:, None, :, None].astype(dt)
    o = (inner + cross).astype(jnp.float32)
    mu = jnp.mean(o, axis=-1, keepdims=True)
    var = jnp.mean(jnp.square(o - mu), axis=-1, keepdims=True)
    o = (o - mu) * lax.rsqrt(var + NORM_EPS)
    return o.transpose(0, 2, 3, 1, 4).reshape(b, s, h * dv).astype(dt)


def setup_inputs(seed: int = 0) -> dict:
    key = jax.random.key(seed)
    ks = jax.random.split(key, 16)
    f32 = jnp.float32

    def dense(k, shape, fan_in):
        return jax.random.normal(k, shape, f32) * (fan_in ** -0.5)

    def gain(k, shape):
        return 1.0 + 0.05 * jax.random.normal(k, shape, f32)

    return {
        "x": jax.random.normal(ks[0], (BATCH, SEQ, D_MODEL), f32),
        "ffn1_norm": gain(ks[1], (DEPTH, D_MODEL)),
        "ffn1_w_gate": dense(ks[2], (DEPTH, D_MODEL, D_FF), D_MODEL),
        "ffn1_w_up": dense(ks[3], (DEPTH, D_MODEL, D_FF), D_MODEL),
        "ffn1_w_down": dense(ks[4], (DEPTH, D_FF, D_MODEL), D_FF),
        "mix_norm": gain(ks[5], (DEPTH, D_MODEL)),
        "w_in": dense(ks[6], (DEPTH, D_MODEL, IN_WIDTH), D_MODEL),
        "w_branch_a": dense(ks[7], (DEPTH, MOBA_W, D_MODEL), MOBA_W),
        "w_branch_b": dense(ks[8], (DEPTH, RET_V_W, D_MODEL), RET_V_W),
        "w_out": dense(ks[9], (DEPTH, D_MODEL, D_MODEL), D_MODEL),
        "ffn2_norm": gain(ks[10], (DEPTH, D_MODEL)),
        "ffn2_w_gate": dense(ks[11], (DEPTH, D_MODEL, D_FF), D_MODEL),
        "ffn2_w_up": dense(ks[12], (DEPTH, D_MODEL, D_FF), D_MODEL),
        "ffn2_w_down": dense(ks[13], (DEPTH, D_FF, D_MODEL), D_FF),
        "final_norm": gain(ks[14], (D_MODEL,)),
    }


def reference(x, ffn1_norm, ffn1_w_gate, ffn1_w_up, ffn1_w_down, mix_norm, w_in, w_branch_a, w_branch_b,
              w_out, ffn2_norm, ffn2_w_gate, ffn2_w_up, ffn2_w_down, final_norm):
    b, s, _ = x.shape
    split_points = []
    acc = 0
    for wdt in IN_SPLITS[:-1]:
        acc += wdt
        split_points.append(acc)
    inv_freq_a = ROPE_THETA ** (-jnp.arange(0, HEAD_DIM, 2, dtype=jnp.float32) / HEAD_DIM)
    inv_freq_r = ROPE_THETA ** (-jnp.linspace(0.0, 1.0, RET_QK_DIM // 2, dtype=jnp.float32))
    cos_a, sin_a = rope_tables(s, inv_freq_a, x.dtype)
    cos_r, sin_r = rope_tables(s, inv_freq_r, x.dtype)

    for l in range(DEPTH):
        x = x + 0.5 * swiglu(rms_norm(x, ffn1_norm[l]), ffn1_w_gate[l], ffn1_w_up[l], ffn1_w_down[l])
        hn = rms_norm(x, mix_norm[l])
        proj = hn @ w_in[l]
        q_a, k_a, v_a, q_r, k_r, v_r, g_r, gate_a, gate_b = jnp.split(proj, split_points, axis=-1)
        q_a = apply_rotary(q_a.reshape(b, s, MOBA_HEADS, HEAD_DIM), cos_a, sin_a)
        k_a = apply_rotary(k_a.reshape(b, s, MOBA_HEADS, HEAD_DIM), cos_a, sin_a)
        y_a = moba_attention(q_a, k_a, v_a.reshape(b, s, MOBA_HEADS, HEAD_DIM))
        q_r = apply_rotary(q_r.reshape(b, s, RET_HEADS, RET_QK_DIM), cos_r, sin_r)
        k_r = apply_rotary(k_r.reshape(b, s, RET_HEADS, RET_QK_DIM), cos_r, sin_r)
        y_r = retention(q_r, k_r, v_r.reshape(b, s, RET_HEADS, RET_V_DIM)) * jax.nn.silu(g_r)
        merged = (jax.nn.sigmoid(gate_a) * (y_a @ w_branch_a[l])
                  + jax.nn.sigmoid(gate_b) * (y_r @ w_branch_b[l]))
        x = x + merged @ w_out[l]
        x = x + 0.5 * swiglu(rms_norm(x, ffn2_norm[l]), ffn2_w_gate[l], ffn2_w_up[l], ffn2_w_down[l])
    return rms_norm(x, final_norm)
```

```cpp
#include <hip/hip_runtime.h>
#include <hip/hip_cooperative_groups.h>
#include <cstdio>
#include <cstdint>
namespace cg = cooperative_groups;

#ifndef PROBE_ID
#define PROBE_ID 0
#endif
#define LAS __attribute__((address_space(3)))
typedef unsigned short bf16_t;
typedef short bf16x8 __attribute__((ext_vector_type(8)));
typedef short s16x4 __attribute__((ext_vector_type(4)));
typedef float f32x4 __attribute__((ext_vector_type(4)));
typedef float f32x2 __attribute__((ext_vector_type(2)));
typedef float f32x16 __attribute__((ext_vector_type(16)));
typedef unsigned u32x4 __attribute__((ext_vector_type(4)));
typedef unsigned u32x2 __attribute__((ext_vector_type(2)));
typedef __bf16 bf16x2_t __attribute__((ext_vector_type(2)));

constexpr int D = 2048, NB = 2, S = 4096, M = NB * S, DFF = 5632, INW = 13312, DEPTH = 2;
constexpr int C_QA = 0, C_KA = 1024, C_VA = 2048, C_QR = 3072, C_KR = 4096, C_VR = 5120, C_GR = 7168, C_GA = 9216, C_GB = 11264;
constexpr int YW = 3072;
constexpr int LDS_BYTES = 155648;
constexpr int LDS_RS = 131072;

constexpr size_t al256(size_t x) { return (x + 255) & ~(size_t)255; }
constexpr size_t WS_WGU1 = 0;
constexpr size_t WS_WD1 = WS_WGU1 + al256((size_t)2 * DFF * D * 2);
constexpr size_t WS_WIN = WS_WD1 + al256((size_t)D * DFF * 2);
constexpr size_t WS_WA = WS_WIN + al256((size_t)INW * D * 2);
constexpr size_t WS_WB = WS_WA + al256((size_t)D * 1024 * 2);
constexpr size_t WS_WO = WS_WB + al256((size_t)D * 2048 * 2);
constexpr size_t WS_WGU2 = WS_WO + al256((size_t)D * D * 2);
constexpr size_t WS_WD2 = WS_WGU2 + al256((size_t)2 * DFF * D * 2);
constexpr size_t WS_X = WS_WD2 + al256((size_t)D * DFF * 2);
constexpr size_t WS_XN = WS_X + al256((size_t)M * D * 4);
constexpr size_t WS_HID = WS_XN + al256((size_t)M * D * 2);
constexpr size_t WS_PROJ = WS_HID + al256((size_t)M * DFF * 2);
constexpr size_t WS_Y = WS_PROJ + al256((size_t)M * INW * 2);
constexpr size_t WS_YR = WS_Y + al256((size_t)M * 1024 * 2);
constexpr size_t WS_KMP = WS_YR + al256((size_t)M * 2048 * 2);
constexpr size_t WS_ROPE = WS_KMP + al256((size_t)2 * 32 * 1024 * 4);
constexpr size_t WS_XB = WS_ROPE + al256((size_t)4 * 4096 * 64 * 4);
constexpr size_t WS_SS = WS_XB + al256((size_t)M * D * 2);
constexpr size_t WS_GRL = WS_SS + al256((size_t)7 * 32 * M * 4);
constexpr size_t WS_CTL = WS_GRL + al256((size_t)M * 2048 * 2);
constexpr size_t CTL_BYTES = 16384;
constexpr size_t WS_END = WS_CTL + CTL_BYTES;

struct Params {
    const float* in[15];
    float* out;
    unsigned char* ws;
};

__device__ __forceinline__ unsigned pk2(float lo, float hi) { f32x2 f = {lo, hi}; bf16x2_t b = __builtin_convertvector(f, bf16x2_t); return __builtin_bit_cast(unsigned, b); }
__device__ __forceinline__ float bflo(unsigned u) { return __uint_as_float(u << 16); }
__device__ __forceinline__ float bfhi(unsigned u) { return __uint_as_float(u & 0xffff0000u); }
__device__ __forceinline__ float fast_rcp(float x) { return __builtin_amdgcn_rcpf(x); }
__device__ __forceinline__ float sigmoidf_(float x) { return fast_rcp(1.0f + __expf(-x)); }
__device__ __forceinline__ float siluf_(float x) { return x * sigmoidf_(x); }
__device__ __forceinline__ float wave_sum(float v) {
#pragma unroll
    for (int o = 1; o < 64; o <<= 1) v += __shfl_xor(v, o);
    return v;
}
__device__ __forceinline__ int otid() { int x = threadIdx.x; asm volatile("" : "+v"(x)); return x; }
__device__ __forceinline__ unsigned char* opq_ptr(unsigned char* q) { int z = 0; asm volatile("" : "+s"(z)); return q + z; }
__device__ __forceinline__ int opq_int(int v) { asm volatile("" : "+s"(v)); return v; }
#define MFMA32(a, b, c) __builtin_amdgcn_mfma_f32_32x32x16_bf16((a), (b), (c), 0, 0, 0)
__device__ __forceinline__ int crow(int reg, int h) { return (reg & 3) + 8 * (reg >> 2) + 4 * h; }
__device__ __forceinline__ s16x4 tr_read(LAS unsigned char* p) { return __builtin_amdgcn_ds_read_tr16_b64_v4i16((LAS s16x4*)p); }
__device__ __forceinline__ bf16x8 tr_read2(LAS unsigned char* p, int hi_off) {
    s16x4 lo = tr_read(p), hi = tr_read(p + hi_off);
    return __builtin_shufflevector(lo, hi, 0, 1, 2, 3, 4, 5, 6, 7);
}
template <int s2> __device__ __forceinline__ bf16x8 pack_step(const f32x16& x) {
    u32x4 p; p.x = pk2(x[8 * s2 + 0], x[8 * s2 + 1]); p.y = pk2(x[8 * s2 + 2], x[8 * s2 + 3]); p.z = pk2(x[8 * s2 + 4], x[8 * s2 + 5]); p.w = pk2(x[8 * s2 + 6], x[8 * s2 + 7]);
    return __builtin_bit_cast(bf16x8, p);
}


#define XB_TMO      128
#define XB_XCNT(j)  (256  + 64 * (j))
#define XB_XSUB(j)  (1280 + 64 * (j))
#define XB_XGEN(j)  (2304 + 64 * (j))
#define XB_TOP      3328
#define XB_TOPGEN   3392
#define XCD_BAR_WORDS 3456
#define XB_SPIN_CAP (1u << 18)
__device__ __forceinline__ unsigned xb_ld(unsigned* p)              { return __hip_atomic_load(p, __ATOMIC_RELAXED, __HIP_MEMORY_SCOPE_AGENT); }
__device__ __forceinline__ unsigned xb_add(unsigned* p, unsigned v) { return __hip_atomic_fetch_add(p, v, __ATOMIC_RELAXED, __HIP_MEMORY_SCOPE_AGENT); }
__device__ __forceinline__ unsigned xb_xcc_id() { return (unsigned)__builtin_amdgcn_s_getreg((3 << 11) | 20) & 0xFu; }
#define XB_SPIN(cond, bar) do { unsigned _sp = 0; while (cond) { __builtin_amdgcn_s_sleep(1); \
    if ((++_sp & 255u) == 0u) { if (xb_ld(&(bar)[XB_TMO])) break; if (_sp > XB_SPIN_CAP) { atomicAdd(&(bar)[XB_TMO], 1u); break; } } } } while (0)
__device__ __forceinline__ void xcd_barrier_post(unsigned* bar) {
    const unsigned x = xb_xcc_id();
    if (threadIdx.x == 0) (void)xb_add(&bar[XB_XCNT(x)], 1u);
}
__device__ __forceinline__ void xcd_barrier_complete(unsigned* bar, unsigned x, unsigned& nloc, unsigned& nx) {
    const unsigned G = gridDim.x * gridDim.y * gridDim.z;
    unsigned sum, cnt, mine, sp = 0u;
    for (;;) {
        sum = 0u; cnt = 0u; mine = 0u;
#pragma unroll
        for (unsigned j = 0; j < 16; ++j) { const unsigned c = xb_ld(&bar[XB_XCNT(j)]); sum += c; cnt += (c > 0u) ? 1u : 0u; mine = (j == x) ? c : mine; }
        if (sum == G) break;
        __builtin_amdgcn_s_sleep(1);
        if ((++sp & 255u) == 0u) { if (xb_ld(&bar[XB_TMO])) break; if (sp > XB_SPIN_CAP) { atomicAdd(&bar[XB_TMO], 1u); break; } }
    }
    nloc = mine > 0u ? mine : 1u; nx = cnt > 0u ? cnt : 1u;
}
__device__ __forceinline__ void xcd_barrier(unsigned char* ws_base, volatile LAS unsigned* st) {
    asm volatile("s_waitcnt vmcnt(0)" ::: "memory");
    __syncthreads();
    if (threadIdx.x == 0) {
        unsigned long long a = (unsigned long long)(ws_base + WS_CTL);
        asm volatile("" : "+s"(a));
        unsigned* bar = (unsigned*)a;
        const unsigned x = xb_xcc_id();
        __builtin_amdgcn_s_waitcnt(0);
        unsigned nloc = st[0], nx = st[1];
        if (nloc == 0u) { xcd_barrier_complete(bar, x, nloc, nx); st[0] = nloc; st[1] = nx; }
        const unsigned old = xb_add(&bar[XB_XSUB(x)], 1u);
        const unsigned gen = old / nloc;
        if (old + 1u == (gen + 1u) * nloc) {
            __builtin_amdgcn_fence(__ATOMIC_RELEASE, "agent");
            asm volatile("s_waitcnt vmcnt(0)" ::: "memory");
            const unsigned og = xb_add(&bar[XB_TOP], 1u);
            const unsigned tg = og / nx;
            if (og + 1u == (tg + 1u) * nx) xb_add(&bar[XB_TOPGEN], 1u);
            else XB_SPIN(xb_ld(&bar[XB_TOPGEN]) == tg, bar);
            __builtin_amdgcn_fence(__ATOMIC_ACQUIRE, "agent");
            xb_add(&bar[XB_XGEN(x)], 1u);
            asm volatile("s_waitcnt vmcnt(0)" ::: "memory");
        } else {
            XB_SPIN(xb_ld(&bar[XB_XGEN(x)]) == gen, bar);
            __builtin_amdgcn_fence(__ATOMIC_ACQUIRE, "agent");
            asm volatile("s_waitcnt vmcnt(0)" ::: "memory");
        }
    }
    __syncthreads();
}

namespace pg8 {
constexpr int BM = 256, BK = 64, HALF = 128, HTB = HALF * BK * 2, STAGE_BYTES = 8 * HTB, NXCD = 8, WGM = 8;
__host__ __device__ __forceinline__ int lds_byte(int r, int c) { const int st = (r >> 4) * 2 + (c >> 5), rr = r & 15, cc = c & 31, ob = rr * 64 + cc * 2; return st * 1024 + (ob ^ (((ob >> 9) & 1) << 5)); }
__host__ __device__ __forceinline__ void stage_rc(int b, int& R, int& C) { const int st = b / 1024, sb = b % 1024, swz = sb ^ (((sb >> 9) & 1) << 5); R = (st >> 1) * 16 + swz / 64; C = (st & 1) * 32 + (swz % 64) / 2; }
__host__ __device__ __forceinline__ int perm32(int rho) { const int n = rho >> 4, i = rho & 15; return 8 * (i >> 2) + 4 * n + (i & 3); }
struct Unit { int pm, pn, ord; };
struct Gemm { const bf16_t* A; const bf16_t* Bt; int M, N, K; };
struct StaticOrder {
    int nM, nN, nwg, G, c;
    __host__ __device__ void init(int M_, int N_, int G_, int c_) { nM = M_ / BM; nN = N_ / BM; nwg = nM * nN; G = G_; c = c_; }
    __host__ __device__ bool next(int i, Unit& u) const {
        const long L = (long)i * G + c; if (L >= nwg) return false;
        int wgid = (int)L; { const int q = nwg / NXCD, r = nwg % NXCD, xcd = wgid % NXCD, off = wgid / NXCD; wgid = (xcd < r ? xcd * (q + 1) : r * (q + 1) + (xcd - r) * q) + off; }
        const int nig = WGM * nN, gid = wgid / nig, fm = gid * WGM, gsz = (nM - fm) < WGM ? (nM - fm) : WGM;
        u.pm = fm + ((wgid % nig) % gsz); u.pn = (wgid % nig) / gsz; u.ord = i; return true;
    }
};
template <class Epi>
__device__ __forceinline__ void gemm_phase(LAS unsigned char* lds, const Gemm g, const StaticOrder& S, const Epi& E) {
    const int tid = otid(), wid = __builtin_amdgcn_readfirstlane(tid >> 6), lane = tid & 63, wr = wid >> 2, wc = wid & 3, fr = lane & 15, fq = lane >> 4;
    const int K = g.K, nt = K / BK;
    unsigned voffA[2], voffB[2];
#pragma unroll
    for (int i = 0; i < 2; ++i) { voffA[i] = (unsigned)(tid * 16 + i * 8192); voffB[i] = voffA[i]; }
    const size_t kstep = (size_t)HTB;
    const size_t hstep = (size_t)(K / BK) * HTB;
    const size_t tstep = 2 * hstep;
    const unsigned ldsw = (unsigned)wid * 1024u;
    const int aoff = lds_byte(wr * 64 + fr, fq * 8), boff = lds_byte(wc * 32 + fr, fq * 8);
#define PG8_SA(b, h) (((b) * 2 + (h)) * HTB)
#define PG8_SB(b, h) ((4 + (b) * 2 + (h)) * HTB)
#define PG8_STAGE(bufoff, gbase, voff) do { _Pragma("unroll") for (int _i = 0; _i < 2; ++_i) \
        __builtin_amdgcn_global_load_lds((const unsigned*)((const char*)(gbase) + (voff)[_i]), (LAS unsigned*)(lds + (bufoff) + ldsw + _i * 8192), 16, 0, 0); } while (0)
#define PG8_LDA(dst, b, h) do { _Pragma("unroll") for (int m = 0; m < 4; ++m) _Pragma("unroll") for (int k = 0; k < 2; ++k) dst[m][k] = *(const LAS bf16x8*)(lds + PG8_SA(b, h) + aoff + m * 2048 + k * 1024); } while (0)
#define PG8_LDB(dst, b, h) do { _Pragma("unroll") for (int n = 0; n < 2; ++n) _Pragma("unroll") for (int k = 0; k < 2; ++k) dst[n][k] = *(const LAS bf16x8*)(lds + PG8_SB(b, h) + boff + n * 2048 + k * 1024); } while (0)
#define PG8_MMA(ai, bj, At, Bt) do { __builtin_amdgcn_s_setprio(1); _Pragma("unroll") for (int m = 0; m < 4; ++m) _Pragma("unroll") for (int n = 0; n < 2; ++n) _Pragma("unroll") for (int k = 0; k < 2; ++k) \
        acc[ai][bj][m][n] = __builtin_amdgcn_mfma_f32_16x16x32_bf16(Bt[n][k], At[m][k], acc[ai][bj][m][n], 0, 0, 0); __builtin_amdgcn_s_setprio(0); } while (0)
#define PG8_WAIT_V(n) asm volatile("s_waitcnt vmcnt(" #n ")" ::: "memory")
#define PG8_WAIT_L(n) asm volatile("s_waitcnt lgkmcnt(" #n ")" ::: "memory")
#define PG8_BAR __builtin_amdgcn_s_barrier()
#define PG8_SCHED __builtin_amdgcn_sched_barrier(0)
    Unit cur, nxt; int ui = 0;
    if (!S.next(0, cur)) return;
    f32x4 acc[2][2][4][2];
#pragma unroll
    for (int a = 0; a < 2; ++a)
#pragma unroll
        for (int b = 0; b < 2; ++b)
#pragma unroll
            for (int m = 0; m < 4; ++m)
#pragma unroll
                for (int n = 0; n < 2; ++n) acc[a][b][m][n] = (f32x4){0.f, 0.f, 0.f, 0.f};
    bf16x8 At[4][2], B0[2][2], B1[2][2];
    const char* cA = (const char*)g.A + (size_t)cur.pm * tstep; const char* cB = (const char*)g.Bt + (size_t)cur.pn * tstep;
    PG8_STAGE(PG8_SB(0, 0), cB, voffB); PG8_STAGE(PG8_SB(0, 1), cB + hstep, voffB); PG8_STAGE(PG8_SA(0, 0), cA, voffA); PG8_STAGE(PG8_SA(0, 1), cA + hstep, voffA);
    if (wr == 1) PG8_BAR;
    PG8_WAIT_V(2); PG8_BAR;
    PG8_STAGE(PG8_SB(1, 0), cB + kstep, voffB); PG8_STAGE(PG8_SA(1, 0), cA + kstep, voffA); PG8_STAGE(PG8_SB(1, 1), cB + hstep + kstep, voffB);
    PG8_WAIT_V(6); PG8_BAR;
    for (;;) {
        const bool has_next = S.next(ui + 1, nxt);
        const char* nA = has_next ? (const char*)g.A + (size_t)nxt.pm * tstep : cA; const char* nB = has_next ? (const char*)g.Bt + (size_t)nxt.pn * tstep : cB;
        for (int t = 0; t < nt; t += 2) {
            const bool last = (t == nt - 2);
            const char* a1 = cA + (size_t)(t + 1) * kstep;
            const char* a2 = last ? nA : cA + (size_t)(t + 2) * kstep; const char* b2 = last ? nB : cB + (size_t)(t + 2) * kstep;
            const char* a3 = a2 + kstep; const char* b3 = b2 + kstep;
            PG8_LDB(B0, 0, 0); PG8_LDB(B1, 0, 1); PG8_SCHED; PG8_LDA(At, 0, 0); PG8_STAGE(PG8_SA(1, 1), a1 + hstep, voffA);
            PG8_WAIT_V(8); PG8_WAIT_L(0); PG8_BAR; PG8_MMA(0, 0, At, B0); PG8_MMA(0, 1, At, B1); PG8_BAR; PG8_SCHED;
            PG8_LDA(At, 0, 1); PG8_STAGE(PG8_SB(0, 0), b2, voffB); PG8_STAGE(PG8_SB(0, 1), b2 + hstep, voffB); PG8_STAGE(PG8_SA(0, 0), a2, voffA);
            PG8_WAIT_V(8); PG8_WAIT_L(0); PG8_BAR; PG8_MMA(1, 0, At, B0); PG8_MMA(1, 1, At, B1); PG8_BAR; PG8_SCHED;
            PG8_LDB(B0, 1, 0); PG8_LDB(B1, 1, 1); PG8_SCHED; PG8_LDA(At, 1, 0); PG8_STAGE(PG8_SA(0, 1), a2 + hstep, voffA);
            PG8_WAIT_V(8); PG8_WAIT_L(0); PG8_BAR; PG8_MMA(0, 0, At, B0); PG8_MMA(0, 1, At, B1); PG8_BAR; PG8_SCHED;
            PG8_LDA(At, 1, 1); PG8_STAGE(PG8_SB(1, 0), b3, voffB); PG8_STAGE(PG8_SB(1, 1), b3 + hstep, voffB); PG8_STAGE(PG8_SA(1, 0), a3, voffA);
            PG8_WAIT_V(8); PG8_WAIT_L(0); PG8_BAR; PG8_MMA(1, 0, At, B0); PG8_MMA(1, 1, At, B1); PG8_BAR; PG8_SCHED;
        }
        if (wr == 0) PG8_BAR;
        E(acc, cur, wr, wc, fr, fq);
        if (!has_next) break;
#pragma unroll
        for (int a = 0; a < 2; ++a)
#pragma unroll
            for (int b = 0; b < 2; ++b)
#pragma unroll
                for (int m = 0; m < 4; ++m)
#pragma unroll
                    for (int n = 0; n < 2; ++n) acc[a][b][m][n] = (f32x4){0.f, 0.f, 0.f, 0.f};
        cur = nxt; cA = nA; cB = nB; ++ui;
        if (wr == 1) PG8_BAR;
    }
    PG8_WAIT_V(0);
    PG8_BAR;
#undef PG8_SA
#undef PG8_SB
#undef PG8_STAGE
#undef PG8_LDA
#undef PG8_LDB
#undef PG8_MMA
#undef PG8_WAIT_V
#undef PG8_WAIT_L
#undef PG8_BAR
#undef PG8_SCHED
}
}
using pg8::Unit;
__device__ __forceinline__ size_t tiled_off(int row, int col, int nkt) {
    return ((size_t)(row >> 7) * nkt + (col >> 6)) * 16384 + (size_t)pg8::lds_byte(row & 127, col & 63);
}
__device__ __forceinline__ int invperm32(int w) { return 16 * ((w >> 2) & 1) + 4 * (w >> 3) + (w & 3); }
typedef f32x4 AccT[2][2][4][2];
__device__ __forceinline__ float row_rstd(const LAS float* RS, int ord, int lrow) {
    const float ssum = RS[ord * 256 + lrow] + RS[2048 + ord * 256 + lrow];
    return 1.0f / sqrtf(ssum * (1.0f / D) + 1e-6f);
}
__device__ __forceinline__ void stage_row_ss(LAS unsigned char* lds, const float* SS, const pg8::StaticOrder& S) {
    LAS float* RS = (LAS float*)(lds + LDS_RS);
    const int tid = otid(), wave = __builtin_amdgcn_readfirstlane(tid >> 6), lane = tid & 63;
    pg8::Unit u;
    if (S.next(wave, u)) {
        const float* sp = SS + u.pm * 256 + lane;
        float a[4];
#pragma unroll
        for (int j = 0; j < 4; ++j) a[j] = 0.f;
#pragma unroll
        for (int t = 0; t < 8; ++t)
#pragma unroll
            for (int j = 0; j < 4; ++j) a[j] += sp[(size_t)t * M + 64 * j];
#pragma unroll
        for (int j = 0; j < 4; ++j) { RS[wave * 256 + lane + 64 * j] = a[j]; RS[2048 + wave * 256 + lane + 64 * j] = 0.f; }
    }
    __syncthreads();
}
struct EpiSwiGLU {
    static constexpr bool PERM = true;
    bf16_t* H; const LAS float* RS;
    __device__ __forceinline__ void operator()(const AccT& acc, const Unit& u, int wr, int wc, int fr, int fq) const {
        const int row0 = u.pm * 256 + wr * 64 + fr, col0 = u.pn * 128 + wc * 32 + 8 * fq;
#pragma unroll
        for (int ai = 0; ai < 2; ++ai)
#pragma unroll
            for (int m = 0; m < 4; ++m) {
                const int row = row0 + ai * 128 + m * 16;
                const float rstd = row_rstd(RS, u.ord, wr * 64 + fr + ai * 128 + m * 16);
                bf16_t* rowp = H + (size_t)row * DFF + col0;
                float v[8];
#pragma unroll
                for (int n = 0; n < 2; ++n)
#pragma unroll
                    for (int e = 0; e < 4; ++e) v[4 * n + e] = siluf_(acc[ai][0][m][n][e] * rstd) * (acc[ai][1][m][n][e] * rstd);
                u32x4 w; w.x = pk2(v[0], v[1]); w.y = pk2(v[2], v[3]); w.z = pk2(v[4], v[5]); w.w = pk2(v[6], v[7]);
                *(u32x4*)((char*)H + tiled_off(row, col0, DFF / 64)) = w;
            }
    }
};
struct EpiResidual {
    static constexpr bool PERM = false;
    const float* src; float* dst; bf16_t* XB; float* SS; LAS float* RSW; float alpha;
    __device__ __forceinline__ void operator()(const AccT& acc, const Unit& u, int wr, int wc, int fr, int fq) const {
        const int row0 = u.pm * 256 + wr * 64 + fr, col0 = u.pn * 256 + wc * 32 + 4 * fq;
#pragma unroll
        for (int ai = 0; ai < 2; ++ai) {
            f32x4 xv[4][2][2];
#pragma unroll
            for (int m = 0; m < 4; ++m)
#pragma unroll
                for (int bj = 0; bj < 2; ++bj)
#pragma unroll
                    for (int n = 0; n < 2; ++n) xv[m][bj][n] = *(const f32x4*)(src + (size_t)(row0 + ai * 128 + m * 16) * D + col0 + bj * 128 + n * 16);
            __builtin_amdgcn_sched_barrier(0);
#pragma unroll
            for (int m = 0; m < 4; ++m) {
                const int row = row0 + ai * 128 + m * 16;
                const size_t ro = (size_t)row * D + col0;
                float ssq = 0.f;
#pragma unroll
                for (int bj = 0; bj < 2; ++bj)
#pragma unroll
                    for (int n = 0; n < 2; ++n) {
                        const f32x4 y = xv[m][bj][n] + alpha * acc[ai][bj][m][n];
                        *(f32x4*)(dst + ro + bj * 128 + n * 16) = y;
                        u32x2 w; w.x = pk2(y[0], y[1]); w.y = pk2(y[2], y[3]);
                        *(u32x2*)((char*)XB + tiled_off(row, col0 + bj * 128 + n * 16, D / 64)) = w;
                        ssq += (y[0] * y[0] + y[1] * y[1]) + (y[2] * y[2] + y[3] * y[3]);
                    }
                ssq += __shfl_xor(ssq, 16); ssq += __shfl_xor(ssq, 32);
                if (fq == 0) RSW[wc * 256 + (row & 255)] = ssq;
            }
            __builtin_amdgcn_sched_barrier(0);
        }
        __syncthreads();
        { const int t = wr * 256 + wc * 64 + fq * 16 + fr;
          if (t < 256) SS[(size_t)u.pn * M + u.pm * 256 + t] = (RSW[t] + RSW[256 + t]) + (RSW[512 + t] + RSW[768 + t]); }
        __syncthreads();
    }
};
struct EpiProj {
    static constexpr bool PERM = true;
    bf16_t* P; float* KMP; const float* rope; const LAS float* RS; bf16_t* GRL;
    __device__ __forceinline__ void operator()(const AccT& acc, const Unit& u, int wr, int wc, int fr, int fq) const {
        const int row0 = u.pm * 256 + wr * 64 + fr, col0 = u.pn * 256 + wc * 32 + 8 * fq;
        const int pn = u.pn;
        const bool rot = (pn < 8) || (pn >= 12 && pn < 20);
        const bool isgr = (pn >= 28 && pn < 36);
        if (!rot) {
#pragma unroll
            for (int ai = 0; ai < 2; ++ai)
#pragma unroll
                for (int m = 0; m < 4; ++m) {
                    const int row = row0 + ai * 128 + m * 16;
                    const float rstd = row_rstd(RS, u.ord, wr * 64 + fr + ai * 128 + m * 16);
                    bf16_t* rowp = P + (size_t)row * INW + col0;
#pragma unroll
                    for (int bj = 0; bj < 2; ++bj) {
                        const f32x4 v0 = acc[ai][bj][m][0] * rstd, v1 = acc[ai][bj][m][1] * rstd;
                        u32x4 w; w.x = pk2(v0[0], v0[1]); w.y = pk2(v0[2], v0[3]); w.z = pk2(v1[0], v1[1]); w.w = pk2(v1[2], v1[3]);
                        if (isgr) {
                            const int sp = row & (S - 1), tl = sp & 127;
                            bf16_t* gb = GRL + ((size_t)(((row >> 12) * 8 + (pn - 28)) * 32 + (sp >> 7))) * 32768
                                       + (size_t)((((((bj * 4 + wc) * 4 + fq) * 4 + (tl >> 5)) * 2) * 32 + (tl & 31)) * 4);
                            u32x2 lo2; lo2.x = w.x; lo2.y = w.y; u32x2 hi2; hi2.x = w.z; hi2.y = w.w;
                            *(u32x2*)gb = lo2; *(u32x2*)(gb + 32 * 4) = hi2;
                        } else *(u32x4*)(rowp + bj * 128) = w;
                    }
                }
            return;
        }
        const bool kindr = pn >= 12;
        const float* ctab = rope + (kindr ? 2 : 0) * (4096 * 64);
        const float* stab = ctab + 4096 * 64;
        const float sc = (pn >= 16 && pn < 20) ? 0.08838834764831845f : 1.0f;
        const bool kmean = (pn >= 4 && pn < 8);
        f32x4 cs[2][2];
#pragma unroll
        for (int bj = 0; bj < 2; ++bj)
#pragma unroll
            for (int n = 0; n < 2; ++n) cs[bj][n] = (f32x4){0.f, 0.f, 0.f, 0.f};
        f32x4 cv[2][4], sv[2][4];
#pragma unroll
        for (int ai = 0; ai < 2; ++ai)
#pragma unroll
            for (int m = 0; m < 4; ++m) {
                const int pos = (row0 + ai * 128 + m * 16) & (S - 1);
                cv[ai][m] = *(const f32x4*)(ctab + pos * 64 + wc * 16 + fq * 4);
                sv[ai][m] = *(const f32x4*)(stab + pos * 64 + wc * 16 + fq * 4);
            }
        __builtin_amdgcn_sched_barrier(0);
#pragma unroll
        for (int ai = 0; ai < 2; ++ai)
#pragma unroll
            for (int m = 0; m < 4; ++m) {
                const int row = row0 + ai * 128 + m * 16;
                const float rs = sc * row_rstd(RS, u.ord, wr * 64 + fr + ai * 128 + m * 16);
                const f32x4 c4 = cv[ai][m] * rs;
                const f32x4 s4 = sv[ai][m] * rs;
                bf16_t* rowp = P + (size_t)row * INW + col0;
#pragma unroll
                for (int bj = 0; bj < 2; ++bj) {
                    const f32x4 x1 = acc[ai][bj][m][0], x2 = acc[ai][bj][m][1];
                    const f32x4 o1 = x1 * c4 - x2 * s4, o2 = x1 * s4 + x2 * c4;
                    cs[bj][0] += o1; cs[bj][1] += o2;
                    u32x4 w; w.x = pk2(o1[0], o1[1]); w.y = pk2(o1[2], o1[3]); w.z = pk2(o2[0], o2[1]); w.w = pk2(o2[2], o2[3]);
                    *(u32x4*)(rowp + bj * 128) = w;
                }
            }
        if (kmean) {
#pragma unroll
            for (int bj = 0; bj < 2; ++bj)
#pragma unroll
                for (int n = 0; n < 2; ++n)
#pragma unroll
                    for (int e = 0; e < 4; ++e) {
                        float v = cs[bj][n][e];
                        v += __shfl_xor(v, 1); v += __shfl_xor(v, 2); v += __shfl_xor(v, 4); v += __shfl_xor(v, 8);
                        cs[bj][n][e] = v;
                    }
            if (fr == 0) {
                float* kp = KMP + ((size_t)wr * 32 + u.pm) * 1024 + (pn - 4) * 256 + wc * 32 + 8 * fq;
#pragma unroll
                for (int bj = 0; bj < 2; ++bj) { *(f32x4*)(kp + bj * 128) = cs[bj][0]; *(f32x4*)(kp + bj * 128 + 4) = cs[bj][1]; }
            }
        }
    }
};
struct EpiBranchB {
    static constexpr bool PERM = true;
    float* T1; const bf16_t* P;
    __device__ __forceinline__ void operator()(const AccT& acc, const Unit& u, int wr, int wc, int fr, int fq) const {
        const int row0 = u.pm * 256 + wr * 64 + fr, col0 = u.pn * 256 + wc * 32 + 8 * fq;
        u32x4 gv[2][4][2];
#pragma unroll
        for (int ai = 0; ai < 2; ++ai)
#pragma unroll
            for (int m = 0; m < 4; ++m)
#pragma unroll
                for (int bj = 0; bj < 2; ++bj) gv[ai][m][bj] = *(const u32x4*)(P + (size_t)(row0 + ai * 128 + m * 16) * INW + C_GB + col0 + bj * 128);
        __builtin_amdgcn_sched_barrier(0);
#pragma unroll
        for (int ai = 0; ai < 2; ++ai)
#pragma unroll
            for (int m = 0; m < 4; ++m) {
                const size_t row = (size_t)(row0 + ai * 128 + m * 16);
#pragma unroll
                for (int bj = 0; bj < 2; ++bj) {
                    const u32x4 g = gv[ai][m][bj];
                    f32x4 o0, o1;
                    o0[0] = sigmoidf_(bflo(g.x)) * acc[ai][bj][m][0][0]; o0[1] = sigmoidf_(bfhi(g.x)) * acc[ai][bj][m][0][1];
                    o0[2] = sigmoidf_(bflo(g.y)) * acc[ai][bj][m][0][2]; o0[3] = sigmoidf_(bfhi(g.y)) * acc[ai][bj][m][0][3];
                    o1[0] = sigmoidf_(bflo(g.z)) * acc[ai][bj][m][1][0]; o1[1] = sigmoidf_(bfhi(g.z)) * acc[ai][bj][m][1][1];
                    o1[2] = sigmoidf_(bflo(g.w)) * acc[ai][bj][m][1][2]; o1[3] = sigmoidf_(bfhi(g.w)) * acc[ai][bj][m][1][3];
                    float* tp = T1 + row * D + col0 + bj * 128;
                    *(f32x4*)tp = o0; *(f32x4*)(tp + 4) = o1;
                }
            }
    }
};
struct EpiBranchA {
    static constexpr bool PERM = true;
    const float* T1; const bf16_t* P; bf16_t* MG;
    __device__ __forceinline__ void operator()(const AccT& acc, const Unit& u, int wr, int wc, int fr, int fq) const {
        const int row0 = u.pm * 256 + wr * 64 + fr, col0 = u.pn * 256 + wc * 32 + 8 * fq;
#pragma unroll
        for (int ai = 0; ai < 2; ++ai)
#pragma unroll
            for (int mp = 0; mp < 2; ++mp) {
                u32x4 gv[2][2]; f32x4 tv[2][2][2];
#pragma unroll
                for (int mi = 0; mi < 2; ++mi)
#pragma unroll
                    for (int bj = 0; bj < 2; ++bj) {
                        const size_t row = (size_t)(row0 + ai * 128 + (2 * mp + mi) * 16);
                        gv[mi][bj] = *(const u32x4*)(P + row * INW + C_GA + col0 + bj * 128);
                        const float* tp = T1 + row * D + col0 + bj * 128;
                        tv[mi][bj][0] = *(const f32x4*)tp; tv[mi][bj][1] = *(const f32x4*)(tp + 4);
                    }
                __builtin_amdgcn_sched_barrier(0);
#pragma unroll
                for (int mi = 0; mi < 2; ++mi)
#pragma unroll
                    for (int bj = 0; bj < 2; ++bj) {
                        const int m = 2 * mp + mi;
                        const size_t row = (size_t)(row0 + ai * 128 + m * 16);
                        const u32x4 g = gv[mi][bj];
                        const f32x4 t0 = tv[mi][bj][0], t1 = tv[mi][bj][1];
                        float o[8];
                        o[0] = t0[0] + sigmoidf_(bflo(g.x)) * acc[ai][bj][m][0][0]; o[1] = t0[1] + sigmoidf_(bfhi(g.x)) * acc[ai][bj][m][0][1];
                        o[2] = t0[2] + sigmoidf_(bflo(g.y)) * acc[ai][bj][m][0][2]; o[3] = t0[3] + sigmoidf_(bfhi(g.y)) * acc[ai][bj][m][0][3];
                        o[4] = t1[0] + sigmoidf_(bflo(g.z)) * acc[ai][bj][m][1][0]; o[5] = t1[1] + sigmoidf_(bfhi(g.z)) * acc[ai][bj][m][1][1];
                        o[6] = t1[2] + sigmoidf_(bflo(g.w)) * acc[ai][bj][m][1][2]; o[7] = t1[3] + sigmoidf_(bfhi(g.w)) * acc[ai][bj][m][1][3];
                        u32x4 w; w.x = pk2(o[0], o[1]); w.y = pk2(o[2], o[3]); w.z = pk2(o[4], o[5]); w.w = pk2(o[6], o[7]);
                        *(u32x4*)((char*)MG + tiled_off((int)row, col0 + bj * 128, D / 64)) = w;
                    }
                __builtin_amdgcn_sched_barrier(0);
            }
    }
};

template <int MAP> __device__ __forceinline__ int rowmap(int n) {
    if (MAP == 1) return (n >> 7) * 256 + (n & 127);
    if (MAP == 2) return (n >> 7) * 256 + 128 + (n & 127);
    if (MAP == 3) {
        const bool rot = (n < 2048) || (n >= 3072 && n < 5120);
        if (!rot) return n;
        const int c = n & 127, i = c & 63, half = c >> 6;
        return (n & ~127) + 32 * (i >> 4) + 8 * ((i >> 2) & 3) + 4 * half + (i & 3);
    }
    return n;
}
template <int MAP, bool HASG, bool PERMW>
__device__ __forceinline__ void transpose_item(const float* W, int K, int N, bf16_t* WT, LAS float* scr, int item, int lane, const float* gk) {
    const int nblk = N / 32, kb = item / nblk, nb = item % nblk, k0 = 64 * kb, n0 = 32 * nb;
#pragma unroll 8
    for (int i = 0; i < 32; ++i) { const int kk = 2 * i + (lane >> 5); scr[kk * 33 + (lane & 31)] = __builtin_nontemporal_load(W + (size_t)(k0 + kk) * N + n0 + (lane & 31)); }
    asm volatile("s_waitcnt lgkmcnt(0)" ::: "memory");
    const int c = lane & 7;
    f32x4 g0 = {1.f, 1.f, 1.f, 1.f}, g1 = {1.f, 1.f, 1.f, 1.f};
    if (HASG) { g0 = *(const f32x4*)(gk + k0 + 8 * c); g1 = *(const f32x4*)(gk + k0 + 8 * c + 4); }
#pragma unroll
    for (int j = 0; j < 4; ++j) { const int n = (lane >> 3) + 8 * j; const LAS float* s = scr + (8 * c) * 33 + n;
        u32x4 o; o.x = pk2(s[0 * 33] * g0[0], s[1 * 33] * g0[1]); o.y = pk2(s[2 * 33] * g0[2], s[3 * 33] * g0[3]); o.z = pk2(s[4 * 33] * g1[0], s[5 * 33] * g1[1]); o.w = pk2(s[6 * 33] * g1[2], s[7 * 33] * g1[3]);
        const int wr_ = rowmap<MAP>(n0 + n), slot_ = PERMW ? ((wr_ & ~31) + invperm32(wr_ & 31)) : wr_;
        *(u32x4*)((char*)WT + tiled_off(slot_, k0 + 8 * c, K / 64)) = o; }
    asm volatile("s_waitcnt lgkmcnt(0)" ::: "memory");
}
template <int MAP, bool HASG = false, bool PERMW = false>
__device__ __forceinline__ void transpose_mat(const float* W, int K, int N, bf16_t* WT, LAS float* scr, int gw, int ngw, int lane, const float* gk = nullptr) {
    const int nitems = (K / 64) * (N / 32);
    for (int it = gw; it < nitems; it += ngw) transpose_item<MAP, HASG, PERMW>(W, K, N, WT, scr, it, lane, gk);
}

template <bool F32OUT>
__device__ __forceinline__ void rms_row(const float* xrow, const float* g, void* orow, int lane) {
    const f32x4* xr = (const f32x4*)xrow + lane;
    f32x4 v[8]; float s = 0.f;
#pragma unroll
    for (int j = 0; j < 8; ++j) { v[j] = xr[64 * j]; s += (v[j].x * v[j].x + v[j].y * v[j].y) + (v[j].z * v[j].z + v[j].w * v[j].w); }
    const float rstd = 1.0f / sqrtf(wave_sum(s) * (1.0f / D) + 1e-6f);
    const f32x4* gr = (const f32x4*)g + lane;
#pragma unroll
    for (int j = 0; j < 8; ++j) {
        const f32x4 gg = gr[64 * j];
        const f32x4 o = v[j] * rstd * gg;
        if (F32OUT) ((f32x4*)orow)[lane + 64 * j] = o;
        else { u32x2 w; w.x = pk2(o.x, o.y); w.y = pk2(o.z, o.w); ((u32x2*)orow)[lane + 64 * j] = w; }
    }
}

constexpr int MB_K = 0, MB_KS = 272, MB_V = 34816, MB_VS = 320, MB_BUF = 75776, MB_KM = 75776, MB_G = 83968, MB_SEL = 92160, MB_ML = 65536, MB_OB = 0;
__device__ __forceinline__ void moba_item(const Params& p, LAS unsigned char* lds, int b, int h, int qb, int half) {
    unsigned char* wsb = opq_ptr(p.ws);
    const bf16_t* PROJ = (const bf16_t*)(wsb + WS_PROJ);
    const float* KMP = (const float*)(wsb + WS_KMP);
    bf16_t* Y = (bf16_t*)(wsb + WS_Y);
    const int tid = otid(), wave = __builtin_amdgcn_readfirstlane(tid >> 6), lane = tid & 63, r = lane & 31, hh = lane >> 5;
    const int wq = wave & 3, team = wave >> 2;
    const int q4 = (lane & 15) >> 2, p4 = lane & 3, b16 = (lane >> 4) & 1;
    const size_t tok0 = (size_t)b * S + qb * 256 + half * 128;
    LAS unsigned char* Kl = lds + MB_K; LAS unsigned char* Vl = lds + MB_V;
    LAS float* KM = (LAS float*)(lds + MB_KM); LAS float* G = (LAS float*)(lds + MB_G); LAS unsigned* SEL = (LAS unsigned*)(lds + MB_SEL);
    LAS float* ML = (LAS float*)(lds + MB_ML); LAS float* OB = (LAS float*)(lds + MB_OB);
    __syncthreads();
    unsigned mymask;
    if (qb > 3) {
        { const int j = tid >> 5, d = (tid & 31) * 4;
          if (j < qb) { const size_t o = ((size_t)(b * 16 + j)) * 1024 + h * 128 + d;
              const f32x4 a = *(const f32x4*)(KMP + o), c = *(const f32x4*)(KMP + 32 * 1024 + o);
              *(LAS f32x4*)(KM + j * 128 + d) = a + c; } }
        __syncthreads();
        { const int qi = tid >> 2, part = tid & 3;
          const u32x4* qp = (const u32x4*)(PROJ + (tok0 + qi) * INW + C_QA + h * 128 + part * 32);
          float qv[32];
#pragma unroll
          for (int c = 0; c < 4; ++c) { const u32x4 t = qp[c];
              qv[8 * c + 0] = bflo(t.x); qv[8 * c + 1] = bfhi(t.x); qv[8 * c + 2] = bflo(t.y); qv[8 * c + 3] = bfhi(t.y);
              qv[8 * c + 4] = bflo(t.z); qv[8 * c + 5] = bfhi(t.z); qv[8 * c + 6] = bflo(t.w); qv[8 * c + 7] = bfhi(t.w); }
          for (int j = 0; j < qb; ++j) {
              const LAS f32x4* km = (const LAS f32x4*)(KM + j * 128 + part * 32);
              float s = 0.f;
#pragma unroll
              for (int c = 0; c < 8; ++c) { const f32x4 k4 = km[c]; s += qv[4 * c] * k4.x + qv[4 * c + 1] * k4.y + qv[4 * c + 2] * k4.z + qv[4 * c + 3] * k4.w; }
              s += __shfl_xor(s, 1); s += __shfl_xor(s, 2);
              if (part == 0) G[qi * 16 + j] = s;
          } }
        __syncthreads();
        if (tid < 128) {
            unsigned mask = 0;
            for (int t = 0; t < 3; ++t) {
                float best = -INFINITY; int bi = 0;
                for (int j = 0; j < qb; ++j) { const float g = G[tid * 16 + j]; const bool ok = !((mask >> j) & 1u) && (g > best); if (ok) { best = g; bi = j; } }
                mask |= 1u << bi;
            }
            SEL[tid] = mask;
        }
        __syncthreads();
        mymask = SEL[32 * wq + r];
    } else mymask = (1u << qb) - 1u;

    bf16x8 qf[8];
    { const bf16_t* qrow = PROJ + (tok0 + 32 * wq + r) * INW + C_QA + h * 128 + 8 * hh;
#pragma unroll
      for (int ks = 0; ks < 8; ++ks) qf[ks] = *(const bf16x8*)(qrow + 16 * ks); }
    f32x16 O[4];
#pragma unroll
    for (int dt = 0; dt < 4; ++dt)
#pragma unroll
        for (int i = 0; i < 16; ++i) O[dt][i] = 0.f;
    float m_run = -1e30f, l_run = 0.f;
    const int nsteps = 2 * (qb + 1);
    const int qloc = 128 * half + 32 * wq + r;
    const float SC = 0.08838834764831845f * 1.4426950408889634f;
    u32x4 kreg[4], vreg[4];
    const int srow = tid >> 4, scol = tid & 15;
#define MOBA_ISSUE_K(step_) do { const int jj_ = (step_) >> 1, blk_ = jj_ == 0 ? qb : jj_ - 1; const int key0_ = blk_ * 256 + ((step_) & 1) * 128; \
        _Pragma("unroll") for (int i_ = 0; i_ < 4; ++i_) { const bf16_t* src_ = PROJ + ((size_t)b * S + key0_ + srow + 32 * i_) * INW + h * 128 + scol * 8; \
            kreg[i_] = *(const u32x4*)(src_ + C_KA); } } while (0)
#define MOBA_ISSUE_V(step_) do { const int jj_ = (step_) >> 1, blk_ = jj_ == 0 ? qb : jj_ - 1; const int key0_ = blk_ * 256 + ((step_) & 1) * 128; \
        _Pragma("unroll") for (int i_ = 0; i_ < 4; ++i_) { const bf16_t* src_ = PROJ + ((size_t)b * S + key0_ + srow + 32 * i_) * INW + h * 128 + scol * 8; \
            vreg[i_] = *(const u32x4*)(src_ + C_VA); } } while (0)
    MOBA_ISSUE_K(0); MOBA_ISSUE_V(0);
#pragma unroll
    for (int i = 0; i < 4; ++i) { *(LAS u32x4*)(Kl + (srow + 32 * i) * MB_KS + scol * 16) = kreg[i]; *(LAS u32x4*)(Vl + (srow + 32 * i) * MB_VS + scol * 16) = vreg[i]; }
    if (nsteps > 1) { MOBA_ISSUE_K(1); MOBA_ISSUE_V(1); }
    for (int step = 0; step < nsteps; ++step) {
        __syncthreads();
        const int cb = (step & 1) * MB_BUF;
        if (step + 1 < nsteps) {
            const int nb = MB_BUF - cb;
#pragma unroll
            for (int i = 0; i < 4; ++i) { *(LAS u32x4*)(Kl + nb + (srow + 32 * i) * MB_KS + scol * 16) = kreg[i]; *(LAS u32x4*)(Vl + nb + (srow + 32 * i) * MB_VS + scol * 16) = vreg[i]; }
            if (step + 2 < nsteps) { MOBA_ISSUE_K(step + 2); MOBA_ISSUE_V(step + 2); }
        }
        const int jj = step >> 1, blk = jj == 0 ? qb : jj - 1;
        const bool own = jj == 0;
        const bool sel = own || ((mymask >> blk) & 1u);
        f32x16 s[2];
#pragma unroll
        for (int kt = 0; kt < 2; ++kt) {
            bf16x8 af[8];
#pragma unroll
            for (int ks = 0; ks < 8; ++ks) af[ks] = *(const LAS bf16x8*)(Kl + cb + (64 * team + 32 * kt + r) * MB_KS + (16 * ks + 8 * hh) * 2);
            __builtin_amdgcn_sched_barrier(0);
#pragma unroll
            for (int i = 0; i < 16; ++i) s[kt][i] = 0.f;
#pragma unroll
            for (int ks = 0; ks < 8; ++ks) s[kt] = MFMA32(af[ks], qf[ks], s[kt]);
            __builtin_amdgcn_sched_barrier(0);
        }
        float tmax = -INFINITY;
        const int kbase = (step & 1) * 128 + 64 * team;
        if (own) {
            asm volatile("" ::: "memory");
#pragma unroll
            for (int kt = 0; kt < 2; ++kt)
#pragma unroll
                for (int i = 0; i < 16; ++i) {
                    const int kl = kbase + 32 * kt + crow(i, hh);
                    const float v = (kl <= qloc) ? s[kt][i] : -INFINITY;
                    s[kt][i] = v; tmax = fmaxf(tmax, v);
                }
        } else {
            asm volatile("" ::: "memory");
#pragma unroll
            for (int kt = 0; kt < 2; ++kt)
#pragma unroll
                for (int i = 0; i < 16; ++i) tmax = fmaxf(tmax, s[kt][i]);
            tmax = sel ? tmax : -INFINITY;
        }
        tmax = fmaxf(tmax, __shfl_xor(tmax, 32)) * SC;
        const float m_new = fmaxf(m_run, tmax);
        const float alpha = __builtin_amdgcn_exp2f(m_run - m_new);
        const float msub = sel ? m_new : INFINITY;
        float psum = 0.f;
#pragma unroll
        for (int kt = 0; kt < 2; ++kt)
#pragma unroll
            for (int i = 0; i < 16; ++i) { const float pv = __builtin_amdgcn_exp2f(__builtin_fmaf(s[kt][i], SC, -msub)); s[kt][i] = pv; psum += pv; }
        psum += __shfl_xor(psum, 32);
        l_run = l_run * alpha + psum; m_run = m_new;
        {
#pragma unroll
            for (int dt = 0; dt < 4; ++dt)
#pragma unroll
                for (int i = 0; i < 16; ++i) O[dt][i] *= alpha;
        }
#pragma unroll
        for (int kt = 0; kt < 2; ++kt) {
            bf16x8 vf0[4], vf1[4];
#pragma unroll
            for (int dt = 0; dt < 4; ++dt) {
                vf0[dt] = tr_read2(Vl + cb + (64 * team + 32 * kt + 4 * hh + q4) * MB_VS + (32 * dt + 16 * b16 + 4 * p4) * 2, 8 * MB_VS);
                vf1[dt] = tr_read2(Vl + cb + (64 * team + 32 * kt + 16 + 4 * hh + q4) * MB_VS + (32 * dt + 16 * b16 + 4 * p4) * 2, 8 * MB_VS);
            }
            const bf16x8 pf0 = pack_step<0>(s[kt]), pf1 = pack_step<1>(s[kt]);
            __builtin_amdgcn_sched_barrier(0);
#pragma unroll
            for (int dt = 0; dt < 4; ++dt) O[dt] = MFMA32(vf0[dt], pf0, O[dt]);
#pragma unroll
            for (int dt = 0; dt < 4; ++dt) O[dt] = MFMA32(vf1[dt], pf1, O[dt]);
            __builtin_amdgcn_sched_barrier(0);
        }
    }
#undef MOBA_ISSUE_K
#undef MOBA_ISSUE_V
    __syncthreads();
    if (team == 1) {
#pragma unroll
        for (int dt = 0; dt < 4; ++dt)
#pragma unroll
            for (int i = 0; i < 16; ++i) OB[((wq * 4 + dt) * 16 + i) * 64 + lane] = O[dt][i];
        ML[(wq * 64 + lane) * 2] = m_run; ML[(wq * 64 + lane) * 2 + 1] = l_run;
    }
    __syncthreads();
    if (team == 0) {
        const float mB = ML[(wq * 64 + lane) * 2], lB = ML[(wq * 64 + lane) * 2 + 1];
        const float mm = fmaxf(m_run, mB), a = __builtin_amdgcn_exp2f(m_run - mm), bsc = __builtin_amdgcn_exp2f(mB - mm);
        const float inv = 1.0f / (l_run * a + lB * bsc);
        const float a2 = a * inv, b2 = bsc * inv;
        bf16_t* yrow = Y + (tok0 + 32 * wq + r) * 1024 + h * 128 + 4 * hh;
#pragma unroll
        for (int dt = 0; dt < 4; ++dt)
#pragma unroll
            for (int g4 = 0; g4 < 4; ++g4) {
                float o[4];
#pragma unroll
                for (int e = 0; e < 4; ++e) o[e] = O[dt][4 * g4 + e] * a2 + OB[((wq * 4 + dt) * 16 + 4 * g4 + e) * 64 + lane] * b2;
                u32x2 w; w.x = pk2(o[0], o[1]); w.y = pk2(o[2], o[3]);
                *(u32x2*)((char*)Y + tiled_off((int)(tok0 + 32 * wq + r), h * 128 + 4 * hh + 32 * dt + 8 * g4, 1024 / 64)) = w;
            }
    }
}

__device__ __forceinline__ float ret_log2g(int h) { const double g = 1.0 - ldexp(1.0, -(5 + h)); return (float)log2(g); }
constexpr int RK_K = 0, RK_KS = 320, RK_V = 40960, RK_VS = 576;
__device__ __forceinline__ void ret_kv_item(const Params& p, LAS unsigned char* lds, int b, int h, int n) {
    unsigned char* wsb = opq_ptr(p.ws);
    const bf16_t* PROJ = (const bf16_t*)(wsb + WS_PROJ);
    float* KV = (float*)(wsb + WS_HID);
    const int tid = otid(), wave = __builtin_amdgcn_readfirstlane(tid >> 6), lane = tid & 63, r = lane & 31, hh = lane >> 5;
    const int q4 = (lane & 15) >> 2, p4 = lane & 3, b16 = (lane >> 4) & 1;
    const size_t tok0 = (size_t)b * S + n * 128;
    const float lg2 = ret_log2g(h);
    LAS unsigned char* Kl = lds + RK_K; LAS unsigned char* Vl = lds + RK_V;
    __syncthreads();
    u32x4 kin[4], vin[8];
#pragma unroll
    for (int i = 0; i < 4; ++i) { const int c = tid + 512 * i, row = c >> 4, cc = c & 15; kin[i] = *(const u32x4*)(PROJ + (tok0 + row) * INW + C_KR + h * 128 + cc * 8); }
#pragma unroll
    for (int i = 0; i < 8; ++i) { const int c = tid + 512 * i, row = c >> 5, cc = c & 31; vin[i] = *(const u32x4*)(PROJ + (tok0 + row) * INW + C_VR + h * 256 + cc * 8); }
    __builtin_amdgcn_sched_barrier(0);
#pragma unroll
    for (int i = 0; i < 4; ++i) {
        const int c = tid + 512 * i, row = c >> 4, cc = c & 15;
        const u32x4 t = kin[i];
        const float z = __builtin_amdgcn_exp2f((float)(127 - row) * lg2);
        u32x4 o; o.x = pk2(bflo(t.x) * z, bfhi(t.x) * z); o.y = pk2(bflo(t.y) * z, bfhi(t.y) * z); o.z = pk2(bflo(t.z) * z, bfhi(t.z) * z); o.w = pk2(bflo(t.w) * z, bfhi(t.w) * z);
        *(LAS u32x4*)(Kl + row * RK_KS + cc * 16) = o;
    }
#pragma unroll
    for (int i = 0; i < 8; ++i) {
        const int c = tid + 512 * i, row = c >> 5, cc = c & 31;
        *(LAS u32x4*)(Vl + row * RK_VS + cc * 16) = vin[i];
    }
    __syncthreads();
    f32x16 acc[4];
#pragma unroll
    for (int dt = 0; dt < 4; ++dt)
#pragma unroll
        for (int i = 0; i < 16; ++i) acc[dt][i] = 0.f;
#pragma unroll
    for (int ks = 0; ks < 8; ++ks) {
        const int m0 = 16 * ks + 8 * hh + q4;
        const bf16x8 af = tr_read2(Vl + m0 * RK_VS + (32 * wave + 16 * b16 + 4 * p4) * 2, 4 * RK_VS);
        bf16x8 bfr[4];
#pragma unroll
        for (int dt = 0; dt < 4; ++dt) bfr[dt] = tr_read2(Kl + m0 * RK_KS + (32 * dt + 16 * b16 + 4 * p4) * 2, 4 * RK_KS);
        if (ks & 1) __builtin_amdgcn_sched_barrier(0);
#pragma unroll
        for (int dt = 0; dt < 4; ++dt) acc[dt] = MFMA32(af, bfr[dt], acc[dt]);
    }
    float* kvp = KV + ((size_t)((b * 8 + h) * 32 + n)) * (256 * 128);
#pragma unroll
    for (int dt = 0; dt < 4; ++dt)
#pragma unroll
        for (int i = 0; i < 16; ++i) kvp[(32 * wave + crow(i, hh)) * 128 + 32 * dt + r] = acc[dt][i];
}

constexpr int RO_K = 0, RO_KS = 272, RO_V = 34816, RO_VS = 576, RO_STAT = 108544;
__device__ __forceinline__ void ret_out_item(const Params& p, LAS unsigned char* lds, int b, int h, int n) {
    unsigned char* wsb = opq_ptr(p.ws);
    const bf16_t* PROJ = (const bf16_t*)(wsb + WS_PROJ);
    const bf16_t* PREVT = (const bf16_t*)(wsb + WS_XN);
    bf16_t* Y = (bf16_t*)(wsb + WS_YR);
    const int tid = otid(), wave = __builtin_amdgcn_readfirstlane(tid >> 6), lane = tid & 63, r = lane & 31, hh = lane >> 5;
    const int q4 = (lane & 15) >> 2, p4 = lane & 3, b16 = (lane >> 4) & 1;
    const int cq = wave & 3, eh = wave >> 2;
    const size_t tok0 = (size_t)b * S + n * 128;
    const float lg2 = ret_log2g(h);
    LAS unsigned char* Kl = lds + RO_K; LAS unsigned char* Vl = lds + RO_V; LAS float* STAT = (LAS float*)(lds + RO_STAT);
    __syncthreads();
    bf16x8 qf[8];
    { const bf16_t* qrow = PROJ + (tok0 + 32 * cq + r) * INW + C_QR + h * 128 + 8 * hh;
#pragma unroll
      for (int ks = 0; ks < 8; ++ks) qf[ks] = *(const bf16x8*)(qrow + 16 * ks); }
    bf16x8 pfr[4][8];
    { const bf16_t* pv = PREVT + ((size_t)((b * 8 + h) * 32 + n)) * (256 * 128) + (size_t)(eh * 32 * 64 + lane) * 8;
#pragma unroll
      for (int et = 0; et < 4; ++et)
#pragma unroll
          for (int ks = 0; ks < 8; ++ks) pfr[et][ks] = *(const bf16x8*)(pv + (size_t)((et * 8 + ks) * 64) * 8); }
    { u32x4 kin[4], vin[4];
#pragma unroll
      for (int i = 0; i < 4; ++i) { const int c = tid + 512 * i, row = c >> 4, cc = c & 15; kin[i] = *(const u32x4*)(PROJ + (tok0 + row) * INW + C_KR + h * 128 + cc * 8); }
#pragma unroll
      for (int i = 0; i < 4; ++i) { const int c = tid + 512 * i, row = c >> 5, cc = c & 31; vin[i] = *(const u32x4*)(PROJ + (tok0 + row) * INW + C_VR + h * 256 + cc * 8); }
      __builtin_amdgcn_sched_barrier(0);
#pragma unroll
      for (int i = 0; i < 4; ++i) { const int c = tid + 512 * i, row = c >> 4, cc = c & 15; *(LAS u32x4*)(Kl + row * RO_KS + cc * 16) = kin[i]; }
#pragma unroll
      for (int i = 0; i < 4; ++i) { const int c = tid + 512 * i, row = c >> 5, cc = c & 31; *(LAS u32x4*)(Vl + row * RO_VS + cc * 16) = vin[i]; }
      __builtin_amdgcn_sched_barrier(0);
#pragma unroll
      for (int i = 0; i < 4; ++i) { const int c = tid + 512 * (i + 4), row = c >> 5, cc = c & 31; vin[i] = *(const u32x4*)(PROJ + (tok0 + row) * INW + C_VR + h * 256 + cc * 8); }
      __builtin_amdgcn_sched_barrier(0);
#pragma unroll
      for (int i = 0; i < 4; ++i) { const int c = tid + 512 * (i + 4), row = c >> 5, cc = c & 31; *(LAS u32x4*)(Vl + row * RO_VS + cc * 16) = vin[i]; }
    }
    f32x16 acc[4];
#pragma unroll
    for (int et = 0; et < 4; ++et)
#pragma unroll
        for (int i = 0; i < 16; ++i) acc[et][i] = 0.f;
#pragma unroll
    for (int et = 0; et < 4; ++et)
#pragma unroll
        for (int ks = 0; ks < 8; ++ks) acc[et] = MFMA32(pfr[et][ks], qf[ks], acc[et]);
    const int cloc = 32 * cq + r;
    { const float xi = __builtin_amdgcn_exp2f((float)(cloc + 1) * lg2);
#pragma unroll
      for (int et = 0; et < 4; ++et)
#pragma unroll
          for (int i = 0; i < 16; ++i) acc[et][i] *= xi; }
    __syncthreads();
    for (int kt = 0; kt <= cq; ++kt) {
        f32x16 s;
#pragma unroll
        for (int i = 0; i < 16; ++i) s[i] = 0.f;
        { bf16x8 af[8];
#pragma unroll
          for (int ks = 0; ks < 8; ++ks) af[ks] = *(const LAS bf16x8*)(Kl + (32 * kt + r) * RO_KS + (16 * ks + 8 * hh) * 2);
          __builtin_amdgcn_sched_barrier(0);
#pragma unroll
          for (int ks = 0; ks < 8; ++ks) s = MFMA32(af[ks], qf[ks], s);
          __builtin_amdgcn_sched_barrier(0); }
#pragma unroll
        for (int i = 0; i < 16; ++i) {
            const int diff = cloc - (32 * kt + crow(i, hh));
            s[i] = diff >= 0 ? s[i] * __builtin_amdgcn_exp2f((float)diff * lg2) : 0.f;
        }
        { bf16x8 vf0[4], vf1[4];
#pragma unroll
          for (int et = 0; et < 4; ++et) {
              vf0[et] = tr_read2(Vl + (32 * kt + 4 * hh + q4) * RO_VS + (128 * eh + 32 * et + 16 * b16 + 4 * p4) * 2, 8 * RO_VS);
              vf1[et] = tr_read2(Vl + (32 * kt + 16 + 4 * hh + q4) * RO_VS + (128 * eh + 32 * et + 16 * b16 + 4 * p4) * 2, 8 * RO_VS); }
          const bf16x8 pf0 = pack_step<0>(s), pf1 = pack_step<1>(s);
          __builtin_amdgcn_sched_barrier(0);
#pragma unroll
          for (int et = 0; et < 4; ++et) acc[et] = MFMA32(vf0[et], pf0, acc[et]);
#pragma unroll
          for (int et = 0; et < 4; ++et) acc[et] = MFMA32(vf1[et], pf1, acc[et]);
          __builtin_amdgcn_sched_barrier(0); }
    }
    float sm = 0.f, sq = 0.f;
#pragma unroll
    for (int et = 0; et < 4; ++et)
#pragma unroll
        for (int i = 0; i < 16; ++i) { sm += acc[et][i]; sq += acc[et][i] * acc[et][i]; }
    sm += __shfl_xor(sm, 32); sq += __shfl_xor(sq, 32);
    if (hh == 0) { STAT[(eh * 128 + cloc) * 2] = sm; STAT[(eh * 128 + cloc) * 2 + 1] = sq; }
    __syncthreads();
    { const float osm = STAT[((eh ^ 1) * 128 + cloc) * 2], osq = STAT[((eh ^ 1) * 128 + cloc) * 2 + 1];
      sm += osm; sq += osq; }
    const float mu = sm * (1.0f / 256.0f);
    const float var = fmaxf(sq * (1.0f / 256.0f) - mu * mu, 0.f);
    const float rstd = 1.0f / sqrtf(var + 1e-6f);
    const size_t tok = tok0 + cloc;
    const bf16_t* grow = (const bf16_t*)(wsb + WS_GRL) + ((size_t)((b * 8 + h) * 32 + n)) * 32768 + (size_t)(((eh * 16 * 4 + cq) * 2 + hh) * 32 + r) * 4;
    bf16_t* yrow = Y + tok * 2048 + h * 256 + 128 * eh + 4 * hh;
    u32x2 gq[4][4];
#pragma unroll
    for (int et = 0; et < 4; ++et)
#pragma unroll
        for (int g4 = 0; g4 < 4; ++g4) gq[et][g4] = *(const u32x2*)(grow + (size_t)((et * 4 + g4) * 4 * 2 * 32 * 4));
    __builtin_amdgcn_sched_barrier(0);
#pragma unroll
    for (int et = 0; et < 4; ++et)
#pragma unroll
        for (int g4 = 0; g4 < 4; ++g4) {
            const u32x2 g = gq[et][g4];
            const float o0 = (acc[et][4 * g4 + 0] - mu) * rstd * siluf_(bflo(g.x));
            const float o1 = (acc[et][4 * g4 + 1] - mu) * rstd * siluf_(bfhi(g.x));
            const float o2 = (acc[et][4 * g4 + 2] - mu) * rstd * siluf_(bflo(g.y));
            const float o3 = (acc[et][4 * g4 + 3] - mu) * rstd * siluf_(bfhi(g.y));
            u32x2 w; w.x = pk2(o0, o1); w.y = pk2(o2, o3);
            *(u32x2*)((char*)Y + tiled_off((int)tok, h * 256 + 128 * eh + 4 * hh + 32 * et + 8 * g4, 2048 / 64)) = w;
        }
}

__global__ void __launch_bounds__(512, 2) mega_fwd(Params p) {
    extern __shared__ __attribute__((aligned(16))) unsigned char smem[];
    LAS unsigned char* lds = (LAS unsigned char*)smem;
    cg::grid_group grid = cg::this_grid();
#define PHASE_IDS const int tid = otid(), wave = __builtin_amdgcn_readfirstlane(tid >> 6), lane = tid & 63, gw = blockIdx.x * 8 + wave; (void)lane; (void)gw
#define PHASE_ENV unsigned char* ws = opq_ptr(p.ws); const int G = opq_int((int)gridDim.x), ngw = G * 8; (void)ws; (void)ngw
#define P_X ((float*)(ws + WS_X))
#define P_XB ((bf16_t*)(ws + WS_XB))
#define P_SS ((float*)(ws + WS_SS))
#define P_HID ((bf16_t*)(ws + WS_HID))
#define P_PROJ ((bf16_t*)(ws + WS_PROJ))
#define P_Y ((bf16_t*)(ws + WS_Y))
#define P_YR ((bf16_t*)(ws + WS_YR))
#define P_KMP ((float*)(ws + WS_KMP))
#define P_ROPE ((float*)(ws + WS_ROPE))
#define P_T1 ((float*)(ws + WS_HID))
#define P_KV ((float*)(ws + WS_HID))
#define P_PREVT ((bf16_t*)(ws + WS_XN))
#define P_MG ((bf16_t*)(ws + WS_XN))
#define P_W(off) ((bf16_t*)(ws + (off)))
    { volatile LAS unsigned* st0 = (volatile LAS unsigned*)(lds + LDS_BYTES - 16);
      if (threadIdx.x < 4) st0[threadIdx.x] = 0u;
      __syncthreads(); }
    xcd_barrier_post((unsigned*)(p.ws + WS_CTL));
    int nsync = 0;
#define GSYNC do { xcd_barrier(p.ws, (volatile LAS unsigned*)(lds + LDS_BYTES - 16)); ++nsync; } while (0)
    if (p.out == nullptr) grid.sync();

    { PHASE_IDS; PHASE_ENV;
    float* ROPE = P_ROPE;
    for (int idx = blockIdx.x * 512 + tid; idx < 2 * 4096 * 64; idx += G * 512) {
        const int kind = idx >> 18, pos = (idx >> 6) & 4095, i = idx & 63;
        const double ex = kind ? (double)i / 63.0 : (double)i / 64.0;
        const float invf = (float)exp(-ex * 9.210340371976184);
        const float ang = (float)pos * invf;
        const double rev = (double)ang * 0.15915494309189535;
        const float fr = (float)(rev - floor(rev));
        ROPE[(kind * 2 + 0) * (4096 * 64) + pos * 64 + i] = __builtin_amdgcn_cosf(fr);
        ROPE[(kind * 2 + 1) * (4096 * 64) + pos * 64 + i] = __builtin_amdgcn_sinf(fr);
    } }

    for (int l = 0; l < DEPTH; ++l) {
        {
            PHASE_IDS; PHASE_ENV;
            LAS float* scr = (LAS float*)(lds + wave * 8448);
            transpose_mat<1, true, true>(p.in[2] + (size_t)l * D * DFF, D, DFF, P_W(WS_WGU1), scr, gw, ngw, lane, p.in[1] + l * D);
            transpose_mat<2, true, true>(p.in[3] + (size_t)l * D * DFF, D, DFF, P_W(WS_WGU1), scr, gw, ngw, lane, p.in[1] + l * D);
            transpose_mat<0>(p.in[4] + (size_t)l * DFF * D, DFF, D, P_W(WS_WD1), scr, gw, ngw, lane);
            transpose_mat<3, true, true>(p.in[6] + (size_t)l * D * INW, D, INW, P_W(WS_WIN), scr, gw, ngw, lane, p.in[5] + l * D);
            transpose_mat<0, false, true>(p.in[7] + (size_t)l * 1024 * D, 1024, D, P_W(WS_WA), scr, gw, ngw, lane);
            transpose_mat<0, false, true>(p.in[8] + (size_t)l * 2048 * D, 2048, D, P_W(WS_WB), scr, gw, ngw, lane);
            transpose_mat<0>(p.in[9] + (size_t)l * D * D, D, D, P_W(WS_WO), scr, gw, ngw, lane);
            transpose_mat<1, true, true>(p.in[11] + (size_t)l * D * DFF, D, DFF, P_W(WS_WGU2), scr, gw, ngw, lane, p.in[10] + l * D);
            transpose_mat<2, true, true>(p.in[12] + (size_t)l * D * DFF, D, DFF, P_W(WS_WGU2), scr, gw, ngw, lane, p.in[10] + l * D);
            transpose_mat<0>(p.in[13] + (size_t)l * DFF * D, DFF, D, P_W(WS_WD2), scr, gw, ngw, lane);
            if (l == 0) {
                float* SSB = P_SS; bf16_t* XB = P_XB; const float* xin = p.in[0];
                for (int m = gw; m < M; m += ngw) {
                    const f32x4* xr = (const f32x4*)(xin + (size_t)m * D) + lane; float sq = 0.f;
                    f32x4 xv8[8];
#pragma unroll
                    for (int j = 0; j < 8; ++j) xv8[j] = xr[64 * j];
                    __builtin_amdgcn_sched_barrier(0);
#pragma unroll
                    for (int j = 0; j < 8; ++j) { const f32x4 v = xv8[j]; sq += (v.x * v.x + v.y * v.y) + (v.z * v.z + v.w * v.w);
                        u32x2 w; w.x = pk2(v.x, v.y); w.y = pk2(v.z, v.w); *(u32x2*)((char*)XB + tiled_off(m, 4 * (lane + 64 * j), D / 64)) = w; }
                    sq = wave_sum(sq);
                    if (lane < 8) SSB[(size_t)lane * M + m] = (lane == 0) ? sq : 0.f;
                }
            }
        }
        GSYNC;
        { PHASE_ENV; pg8::StaticOrder SO; pg8::Gemm g{P_XB, P_W(WS_WGU1), M, 2 * DFF, D}; SO.init(M, 2 * DFF, G, blockIdx.x); stage_row_ss(lds, P_SS + (size_t)(3 * l) * 8 * M, SO); EpiSwiGLU E{P_HID, (const LAS float*)(lds + LDS_RS)}; pg8::gemm_phase(lds, g, SO, E); }
        GSYNC;
        { PHASE_ENV; pg8::StaticOrder SO; pg8::Gemm g{P_HID, P_W(WS_WD1), M, D, DFF}; SO.init(M, D, G, blockIdx.x); EpiResidual E{(l == 0) ? p.in[0] : P_X, P_X, P_XB, P_SS + (size_t)(3 * l + 1) * 8 * M, (LAS float*)(lds + LDS_RS), 0.5f}; pg8::gemm_phase(lds, g, SO, E); }
        GSYNC;
        { PHASE_ENV; pg8::StaticOrder SO; pg8::Gemm g{P_XB, P_W(WS_WIN), M, INW, D}; SO.init(M, INW, G, blockIdx.x); stage_row_ss(lds, P_SS + (size_t)(3 * l + 1) * 8 * M, SO); EpiProj E{P_PROJ, P_KMP, P_ROPE, (const LAS float*)(lds + LDS_RS), (bf16_t*)(ws + WS_GRL)}; pg8::gemm_phase(lds, g, SO, E); }
        GSYNC;
        { PHASE_ENV;
        for (int pair = blockIdx.x; pair < 256; pair += G) {
            const int bh = pair >> 4, q16 = pair & 15;
            moba_item(p, lds, bh >> 3, bh & 7, q16, 0);
            moba_item(p, lds, bh >> 3, bh & 7, 15 - q16, 1);
        }
        for (int it = blockIdx.x; it < 512; it += G) ret_kv_item(p, lds, it >> 8, (it >> 5) & 7, it & 31);
        }
        GSYNC;
        { PHASE_IDS; PHASE_ENV;
        for (int idx = blockIdx.x * 512 + tid; idx < 16 * 32768; idx += G * 512) {
            const int bh = idx >> 15, ed = idx & 32767, h = bh & 7;
            const float decay = __builtin_amdgcn_exp2f(128.0f * ret_log2g(h));
            const float* kv = P_KV + (size_t)bh * 32 * 32768 + ed;
            const int e_ = ed >> 7, d_ = ed & 127;
            const int foff = ((((e_ >> 7) * 4 + ((e_ >> 5) & 3)) * 8 + (d_ >> 4)) * 64 + ((d_ >> 3) & 1) * 32 + (e_ & 31)) * 8 + (d_ & 7);
            bf16_t* pt = P_PREVT + (size_t)bh * 32 * 32768 + foff;
            float kvv[32];
#pragma unroll
            for (int n = 0; n < 32; ++n) kvv[n] = kv[(size_t)n * 32768];
            float st = 0.f;
#pragma unroll
            for (int n = 0; n < 32; ++n) {
                pt[(size_t)n * 32768] = (bf16_t)(pk2(st, 0.f) & 0xffffu);
                st = decay * st + kvv[n];
            }
        } }
        GSYNC;
        { PHASE_ENV;
        for (int it = blockIdx.x; it < 512; it += G) ret_out_item(p, lds, it >> 8, (it >> 5) & 7, it & 31);
        }
        GSYNC;
        { PHASE_ENV; pg8::StaticOrder SO; pg8::Gemm g{P_YR, P_W(WS_WB), M, D, 2048}; SO.init(M, D, G, blockIdx.x); EpiBranchB E{P_T1, P_PROJ}; pg8::gemm_phase(lds, g, SO, E); }
        { PHASE_ENV; pg8::StaticOrder SO; pg8::Gemm g{P_Y, P_W(WS_WA), M, D, 1024}; SO.init(M, D, G, blockIdx.x); EpiBranchA E{P_T1, P_PROJ, P_MG}; pg8::gemm_phase(lds, g, SO, E); }
        GSYNC;
        { PHASE_ENV; pg8::StaticOrder SO; pg8::Gemm g{P_MG, P_W(WS_WO), M, D, D}; SO.init(M, D, G, blockIdx.x); EpiResidual E{P_X, P_X, P_XB, P_SS + (size_t)(3 * l + 2) * 8 * M, (LAS float*)(lds + LDS_RS), 1.0f}; pg8::gemm_phase(lds, g, SO, E); }
        GSYNC;
        { PHASE_ENV; pg8::StaticOrder SO; pg8::Gemm g{P_XB, P_W(WS_WGU2), M, 2 * DFF, D}; SO.init(M, 2 * DFF, G, blockIdx.x); stage_row_ss(lds, P_SS + (size_t)(3 * l + 2) * 8 * M, SO); EpiSwiGLU E{P_HID, (const LAS float*)(lds + LDS_RS)}; pg8::gemm_phase(lds, g, SO, E); }
        GSYNC;
        { PHASE_ENV; pg8::StaticOrder SO; pg8::Gemm g{P_HID, P_W(WS_WD2), M, D, DFF}; SO.init(M, D, G, blockIdx.x); EpiResidual E{P_X, P_X, P_XB, P_SS + (size_t)(3 * l + 3) * 8 * M, (LAS float*)(lds + LDS_RS), 0.5f}; pg8::gemm_phase(lds, g, SO, E); }
        GSYNC;
    }
    { PHASE_IDS; PHASE_ENV;
    for (int m = gw; m < M; m += ngw) rms_row<true>(P_X + (size_t)m * D, p.in[14], p.out + (size_t)m * D, lane); }
}

extern "C" void kernel_launch(void* const* d_in, const int* in_sizes, int n_in, void* d_out, int out_size, void* d_ws, size_t ws_size, hipStream_t stream) {
    static int grid = 0;
    if (grid == 0) {
        if (n_in != 15 || ws_size < WS_END) { fprintf(stderr, "kernel_launch: n_in %d ws %zu need %zu\n", n_in, ws_size, (size_t)WS_END); grid = -1; return; }
        int dev = 0, cus = 0, per_cu = 0;
        hipGetDevice(&dev);
        hipDeviceGetAttribute(&cus, hipDeviceAttributeMultiprocessorCount, dev);
        hipFuncSetAttribute((const void*)mega_fwd, hipFuncAttributeMaxDynamicSharedMemorySize, LDS_BYTES);
        hipOccupancyMaxActiveBlocksPerMultiprocessor(&per_cu, (const void*)mega_fwd, 512, LDS_BYTES);
        if (per_cu < 1) { fprintf(stderr, "kernel_launch: occupancy query says %d blocks per CU\n", per_cu); per_cu = 1; }
        (void)hipGetLastError();
        grid = cus * per_cu;
        if (grid > 256) grid = 256;
    }
    if (grid < 0) return;
    if (hipMemsetAsync((char*)d_ws + WS_CTL, 0, CTL_BYTES, stream) != hipSuccess) { fprintf(stderr, "memset failed\n"); return; }
    Params p{};
    for (int i = 0; i < 15; ++i) p.in[i] = (const float*)d_in[i];
    p.out = (float*)d_out; p.ws = (unsigned char*)d_ws;
    void* args[] = {&p};
    hipError_t e = hipLaunchCooperativeKernel((const void*)mega_fwd, dim3(grid), dim3(512), args, LDS_BYTES, stream);
    if (e != hipSuccess) fprintf(stderr, "cooperative launch failed: %s (grid %d)\n", hipGetErrorString(e), grid);
}
```

```cpp
#include <hip/hip_runtime.h>
#include <hip/hip_cooperative_groups.h>
#include <cstdio>
#include <cstdint>
namespace cg = cooperative_groups;

#ifndef PROBE_ID
#define PROBE_ID 0
#endif
#define LAS __attribute__((address_space(3)))
typedef unsigned short bf16_t;
typedef short bf16x8 __attribute__((ext_vector_type(8)));
typedef short s16x4 __attribute__((ext_vector_type(4)));
typedef float f32x4 __attribute__((ext_vector_type(4)));
typedef float f32x2 __attribute__((ext_vector_type(2)));
typedef float f32x16 __attribute__((ext_vector_type(16)));
typedef unsigned u32x4 __attribute__((ext_vector_type(4)));
typedef unsigned u32x2 __attribute__((ext_vector_type(2)));
typedef __bf16 bf16x2_t __attribute__((ext_vector_type(2)));

constexpr int D = 2048, NB = 2, S = 4096, M = NB * S, DFF = 5632, INW = 13312, DEPTH = 2;
constexpr int C_QA = 0, C_KA = 1024, C_VA = 2048, C_QR = 3072, C_KR = 4096, C_VR = 5120, C_GR = 7168, C_GA = 9216, C_GB = 11264;
constexpr int YW = 3072;
constexpr int LDS_BYTES = 155648;
constexpr int LDS_RS = 131072;

constexpr size_t al256(size_t x) { return (x + 255) & ~(size_t)255; }
constexpr size_t WS_WGU1 = 0;
constexpr size_t WS_WD1 = WS_WGU1 + al256((size_t)2 * DFF * D * 2);
constexpr size_t WS_WIN = WS_WD1 + al256((size_t)D * DFF * 2);
constexpr size_t WS_WA = WS_WIN + al256((size_t)INW * D * 2);
constexpr size_t WS_WB = WS_WA + al256((size_t)D * 1024 * 2);
constexpr size_t WS_WO = WS_WB + al256((size_t)D * 2048 * 2);
constexpr size_t WS_WGU2 = WS_WO + al256((size_t)D * D * 2);
constexpr size_t WS_WD2 = WS_WGU2 + al256((size_t)2 * DFF * D * 2);
constexpr size_t WS_X = WS_WD2 + al256((size_t)D * DFF * 2);
constexpr size_t WS_XN = WS_X + al256((size_t)M * D * 4);
constexpr size_t WS_HID = WS_XN + al256((size_t)M * D * 2);
constexpr size_t WS_PROJ = WS_HID + al256((size_t)M * DFF * 2);
constexpr size_t WS_Y = WS_PROJ + al256((size_t)M * INW * 2);
constexpr size_t WS_YR = WS_Y + al256((size_t)M * 1024 * 2);
constexpr size_t WS_KMP = WS_YR + al256((size_t)M * 2048 * 2);
constexpr size_t WS_ROPE = WS_KMP + al256((size_t)2 * 32 * 1024 * 4);
constexpr size_t WS_XB = WS_ROPE + al256((size_t)4 * 4096 * 64 * 4);
constexpr size_t WS_SS = WS_XB + al256((size_t)M * D * 2);
constexpr size_t WS_GRL = WS_SS + al256((size_t)7 * 32 * M * 4);
constexpr size_t WS_CTL = WS_GRL + al256((size_t)M * 2048 * 2);
constexpr size_t CTL_BYTES = 16384;
constexpr size_t WS_END = WS_CTL + CTL_BYTES;

struct Params {
    const float* in[15];
    float* out;
    unsigned char* ws;
};

__device__ __forceinline__ unsigned pk2(float lo, float hi) { f32x2 f = {lo, hi}; bf16x2_t b = __builtin_convertvector(f, bf16x2_t); return __builtin_bit_cast(unsigned, b); }
__device__ __forceinline__ float bflo(unsigned u) { return __uint_as_float(u << 16); }
__device__ __forceinline__ float bfhi(unsigned u) { return __uint_as_float(u & 0xffff0000u); }
__device__ __forceinline__ float fast_rcp(float x) { return __builtin_amdgcn_rcpf(x); }
__device__ __forceinline__ float sigmoidf_(float x) { return fast_rcp(1.0f + __expf(-x)); }
__device__ __forceinline__ float siluf_(float x) { return x * sigmoidf_(x); }
__device__ __forceinline__ float wave_sum(float v) {
#pragma unroll
    for (int o = 1; o < 64; o <<= 1) v += __shfl_xor(v, o);
    return v;
}
__device__ __forceinline__ int otid() { int x = threadIdx.x; asm volatile("" : "+v"(x)); return x; }
__device__ __forceinline__ unsigned char* opq_ptr(unsigned char* q) { int z = 0; asm volatile("" : "+s"(z)); return q + z; }
__device__ __forceinline__ int opq_int(int v) { asm volatile("" : "+s"(v)); return v; }
#define MFMA32(a, b, c) __builtin_amdgcn_mfma_f32_32x32x16_bf16((a), (b), (c), 0, 0, 0)
__device__ __forceinline__ int crow(int reg, int h) { return (reg & 3) + 8 * (reg >> 2) + 4 * h; }
__device__ __forceinline__ s16x4 tr_read(LAS unsigned char* p) { return __builtin_amdgcn_ds_read_tr16_b64_v4i16((LAS s16x4*)p); }
__device__ __forceinline__ bf16x8 tr_read2(LAS unsigned char* p, int hi_off) {
    s16x4 lo = tr_read(p), hi = tr_read(p + hi_off);
    return __builtin_shufflevector(lo, hi, 0, 1, 2, 3, 4, 5, 6, 7);
}
template <int s2> __device__ __forceinline__ bf16x8 pack_step(const f32x16& x) {
    u32x4 p; p.x = pk2(x[8 * s2 + 0], x[8 * s2 + 1]); p.y = pk2(x[8 * s2 + 2], x[8 * s2 + 3]); p.z = pk2(x[8 * s2 + 4], x[8 * s2 + 5]); p.w = pk2(x[8 * s2 + 6], x[8 * s2 + 7]);
    return __builtin_bit_cast(bf16x8, p);
}


#define XB_TMO      128
#define XB_XCNT(j)  (256  + 64 * (j))
#define XB_XSUB(j)  (1280 + 64 * (j))
#define XB_XGEN(j)  (2304 + 64 * (j))
#define XB_TOP      3328
#define XB_TOPGEN   3392
#define XCD_BAR_WORDS 3456
#define XB_SPIN_CAP (1u << 18)
__device__ __forceinline__ unsigned xb_ld(unsigned* p)              { return __hip_atomic_load(p, __ATOMIC_RELAXED, __HIP_MEMORY_SCOPE_AGENT); }
__device__ __forceinline__ unsigned xb_add(unsigned* p, unsigned v) { return __hip_atomic_fetch_add(p, v, __ATOMIC_RELAXED, __HIP_MEMORY_SCOPE_AGENT); }
__device__ __forceinline__ unsigned xb_xcc_id() { return (unsigned)__builtin_amdgcn_s_getreg((3 << 11) | 20) & 0xFu; }
#define XB_SPIN(cond, bar) do { unsigned _sp = 0; while (cond) { __builtin_amdgcn_s_sleep(1); \
    if ((++_sp & 255u) == 0u) { if (xb_ld(&(bar)[XB_TMO])) break; if (_sp > XB_SPIN_CAP) { atomicAdd(&(bar)[XB_TMO], 1u); break; } } } } while (0)
__device__ __forceinline__ void xcd_barrier_post(unsigned* bar) {
    const unsigned x = xb_xcc_id();
    if (threadIdx.x == 0) (void)xb_add(&bar[XB_XCNT(x)], 1u);
}
__device__ __forceinline__ void xcd_barrier_complete(unsigned* bar, unsigned x, unsigned& nloc, unsigned& nx) {
    const unsigned G = gridDim.x * gridDim.y * gridDim.z;
    unsigned sum, cnt, mine, sp = 0u;
    for (;;) {
        sum = 0u; cnt = 0u; mine = 0u;
#pragma unroll
        for (unsigned j = 0; j < 16; ++j) { const unsigned c = xb_ld(&bar[XB_XCNT(j)]); sum += c; cnt += (c > 0u) ? 1u : 0u; mine = (j == x) ? c : mine; }
        if (sum == G) break;
        __builtin_amdgcn_s_sleep(1);
        if ((++sp & 255u) == 0u) { if (xb_ld(&bar[XB_TMO])) break; if (sp > XB_SPIN_CAP) { atomicAdd(&bar[XB_TMO], 1u); break; } }
    }
    nloc = mine > 0u ? mine : 1u; nx = cnt > 0u ? cnt : 1u;
}
__device__ __forceinline__ void xcd_barrier(unsigned char* ws_base, volatile LAS unsigned* st) {
    asm volatile("s_waitcnt vmcnt(0)" ::: "memory");
    __syncthreads();
    if (threadIdx.x == 0) {
        unsigned long long a = (unsigned long long)(ws_base + WS_CTL);
        asm volatile("" : "+s"(a));
        unsigned* bar = (unsigned*)a;
        const unsigned x = xb_xcc_id();
        __builtin_amdgcn_s_waitcnt(0);
        unsigned nloc = st[0], nx = st[1];
        if (nloc == 0u) { xcd_barrier_complete(bar, x, nloc, nx); st[0] = nloc; st[1] = nx; }
        const unsigned old = xb_add(&bar[XB_XSUB(x)], 1u);
        const unsigned gen = old / nloc;
        if (old + 1u == (gen + 1u) * nloc) {
            __builtin_amdgcn_fence(__ATOMIC_RELEASE, "agent");
            asm volatile("s_waitcnt vmcnt(0)" ::: "memory");
            const unsigned og = xb_add(&bar[XB_TOP], 1u);
            const unsigned tg = og / nx;
            if (og + 1u == (tg + 1u) * nx) xb_add(&bar[XB_TOPGEN], 1u);
            else XB_SPIN(xb_ld(&bar[XB_TOPGEN]) == tg, bar);
            __builtin_amdgcn_fence(__ATOMIC_ACQUIRE, "agent");
            xb_add(&bar[XB_XGEN(x)], 1u);
            asm volatile("s_waitcnt vmcnt(0)" ::: "memory");
        } else {
            XB_SPIN(xb_ld(&bar[XB_XGEN(x)]) == gen, bar);
            __builtin_amdgcn_fence(__ATOMIC_ACQUIRE, "agent");
            asm volatile("s_waitcnt vmcnt(0)" ::: "memory");
        }
    }
    __syncthreads();
}

namespace pg8 {
constexpr int BM = 256, BK = 64, HALF = 128, HTB = HALF * BK * 2, STAGE_BYTES = 8 * HTB, NXCD = 8, WGM = 8;
__host__ __device__ __forceinline__ int lds_byte(int r, int c) { const int st = (r >> 4) * 2 + (c >> 5), rr = r & 15, cc = c & 31, ob = rr * 64 + cc * 2; return st * 1024 + (ob ^ (((ob >> 9) & 1) << 5)); }
__host__ __device__ __forceinline__ void stage_rc(int b, int& R, int& C) { const int st = b / 1024, sb = b % 1024, swz = sb ^ (((sb >> 9) & 1) << 5); R = (st >> 1) * 16 + swz / 64; C = (st & 1) * 32 + (swz % 64) / 2; }
__host__ __device__ __forceinline__ int perm32(int rho) { const int n = rho >> 4, i = rho & 15; return 8 * (i >> 2) + 4 * n + (i & 3); }
struct Unit { int pm, pn, ord; };
struct Gemm { const bf16_t* A; const bf16_t* Bt; int M, N, K; };
struct StaticOrder {
    int nM, nN, nwg, G, c;
    __host__ __device__ void init(int M_, int N_, int G_, int c_) { nM = M_ / BM; nN = N_ / BM; nwg = nM * nN; G = G_; c = c_; }
    __host__ __device__ bool next(int i, Unit& u) const {
        const long L = (long)i * G + c; if (L >= nwg) return false;
        int wgid = (int)L; { const int q = nwg / NXCD, r = nwg % NXCD, xcd = wgid % NXCD, off = wgid / NXCD; wgid = (xcd < r ? xcd * (q + 1) : r * (q + 1) + (xcd - r) * q) + off; }
        const int nig = WGM * nN, gid = wgid / nig, fm = gid * WGM, gsz = (nM - fm) < WGM ? (nM - fm) : WGM;
        u.pm = fm + ((wgid % nig) % gsz); u.pn = (wgid % nig) / gsz; u.ord = i; return true;
    }
};
template <class Epi>
__device__ __forceinline__ void gemm_phase(LAS unsigned char* lds, const Gemm g, const StaticOrder& S, const Epi& E) {
    const int tid = otid(), wid = __builtin_amdgcn_readfirstlane(tid >> 6), lane = tid & 63, wr = wid >> 2, wc = wid & 3, fr = lane & 15, fq = lane >> 4;
    const int K = g.K, nt = K / BK;
    unsigned voffA[2], voffB[2];
#pragma unroll
    for (int i = 0; i < 2; ++i) { voffA[i] = (unsigned)(tid * 16 + i * 8192); voffB[i] = voffA[i]; }
    const size_t kstep = (size_t)HTB;
    const size_t hstep = (size_t)(K / BK) * HTB;
    const size_t tstep = 2 * hstep;
    const unsigned ldsw = (unsigned)wid * 1024u;
    const int aoff = lds_byte(wr * 64 + fr, fq * 8), boff = lds_byte(wc * 32 + fr, fq * 8);
#define PG8_SA(b, h) (((b) * 2 + (h)) * HTB)
#define PG8_SB(b, h) ((4 + (b) * 2 + (h)) * HTB)
#define PG8_STAGE(bufoff, gbase, voff) do { _Pragma("unroll") for (int _i = 0; _i < 2; ++_i) \
        __builtin_amdgcn_global_load_lds((const unsigned*)((const char*)(gbase) + (voff)[_i]), (LAS unsigned*)(lds + (bufoff) + ldsw + _i * 8192), 16, 0, 0); } while (0)
#define PG8_LDA(dst, b, h) do { _Pragma("unroll") for (int m = 0; m < 4; ++m) _Pragma("unroll") for (int k = 0; k < 2; ++k) dst[m][k] = *(const LAS bf16x8*)(lds + PG8_SA(b, h) + aoff + m * 2048 + k * 1024); } while (0)
#define PG8_LDB(dst, b, h) do { _Pragma("unroll") for (int n = 0; n < 2; ++n) _Pragma("unroll") for (int k = 0; k < 2; ++k) dst[n][k] = *(const LAS bf16x8*)(lds + PG8_SB(b, h) + boff + n * 2048 + k * 1024); } while (0)
#define PG8_MMA(ai, bj, At, Bt) do { __builtin_amdgcn_s_setprio(1); _Pragma("unroll") for (int m = 0; m < 4; ++m) _Pragma("unroll") for (int n = 0; n < 2; ++n) _Pragma("unroll") for (int k = 0; k < 2; ++k) \
        acc[ai][bj][m][n] = __builtin_amdgcn_mfma_f32_16x16x32_bf16(Bt[n][k], At[m][k], acc[ai][bj][m][n], 0, 0, 0); __builtin_amdgcn_s_setprio(0); } while (0)
#define PG8_WAIT_V(n) asm volatile("s_waitcnt vmcnt(" #n ")" ::: "memory")
#define PG8_WAIT_L(n) asm volatile("s_waitcnt lgkmcnt(" #n ")" ::: "memory")
#define PG8_BAR __builtin_amdgcn_s_barrier()
#define PG8_SCHED __builtin_amdgcn_sched_barrier(0)
    Unit cur, nxt; int ui = 0;
    if (!S.next(0, cur)) return;
    f32x4 acc[2][2][4][2];
#pragma unroll
    for (int a = 0; a < 2; ++a)
#pragma unroll
        for (int b = 0; b < 2; ++b)
#pragma unroll
            for (int m = 0; m < 4; ++m)
#pragma unroll
                for (int n = 0; n < 2; ++n) acc[a][b][m][n] = (f32x4){0.f, 0.f, 0.f, 0.f};
    bf16x8 At[4][2], B0[2][2], B1[2][2];
    const char* cA = (const char*)g.A + (size_t)cur.pm * tstep; const char* cB = (const char*)g.Bt + (size_t)cur.pn * tstep;
    PG8_STAGE(PG8_SB(0, 0), cB, voffB); PG8_STAGE(PG8_SB(0, 1), cB + hstep, voffB); PG8_STAGE(PG8_SA(0, 0), cA, voffA); PG8_STAGE(PG8_SA(0, 1), cA + hstep, voffA);
    if (wr == 1) PG8_BAR;
    PG8_WAIT_V(2); PG8_BAR;
    PG8_STAGE(PG8_SB(1, 0), cB + kstep, voffB); PG8_STAGE(PG8_SA(1, 0), cA + kstep, voffA); PG8_STAGE(PG8_SB(1, 1), cB + hstep + kstep, voffB);
    PG8_WAIT_V(6); PG8_BAR;
    for (;;) {
        const bool has_next = S.next(ui + 1, nxt);
        const char* nA = has_next ? (const char*)g.A + (size_t)nxt.pm * tstep : cA; const char* nB = has_next ? (const char*)g.Bt + (size_t)nxt.pn * tstep : cB;
        for (int t = 0; t < nt; t += 2) {
            const bool last = (t == nt - 2);
            const char* a1 = cA + (size_t)(t + 1) * kstep;
            const char* a2 = last ? nA : cA + (size_t)(t + 2) * kstep; const char* b2 = last ? nB : cB + (size_t)(t + 2) * kstep;
            const char* a3 = a2 + kstep; const char* b3 = b2 + kstep;
            PG8_LDB(B0, 0, 0); PG8_LDB(B1, 0, 1); PG8_SCHED; PG8_LDA(At, 0, 0); PG8_STAGE(PG8_SA(1, 1), a1 + hstep, voffA);
            PG8_WAIT_V(8); PG8_WAIT_L(0); PG8_BAR; PG8_MMA(0, 0, At, B0); PG8_MMA(0, 1, At, B1); PG8_BAR; PG8_SCHED;
            PG8_LDA(At, 0, 1); PG8_STAGE(PG8_SB(0, 0), b2, voffB); PG8_STAGE(PG8_SB(0, 1), b2 + hstep, voffB); PG8_STAGE(PG8_SA(0, 0), a2, voffA);
            PG8_WAIT_V(8); PG8_WAIT_L(0); PG8_BAR; PG8_MMA(1, 0, At, B0); PG8_MMA(1, 1, At, B1); PG8_BAR; PG8_SCHED;
            PG8_LDB(B0, 1, 0); PG8_LDB(B1, 1, 1); PG8_SCHED; PG8_LDA(At, 1, 0); PG8_STAGE(PG8_SA(0, 1), a2 + hstep, voffA);
            PG8_WAIT_V(8); PG8_WAIT_L(0); PG8_BAR; PG8_MMA(0, 0, At, B0); PG8_MMA(0, 1, At, B1); PG8_BAR; PG8_SCHED;
            PG8_LDA(At, 1, 1); PG8_STAGE(PG8_SB(1, 0), b3, voffB); PG8_STAGE(PG8_SB(1, 1), b3 + hstep, voffB); PG8_STAGE(PG8_SA(1, 0), a3, voffA);
            PG8_WAIT_V(8); PG8_WAIT_L(0); PG8_BAR; PG8_MMA(1, 0, At, B0); PG8_MMA(1, 1, At, B1); PG8_BAR; PG8_SCHED;
        }
        if (wr == 0) PG8_BAR;
        E(acc, cur, wr, wc, fr, fq);
        if (!has_next) break;
#pragma unroll
        for (int a = 0; a < 2; ++a)
#pragma unroll
            for (int b = 0; b < 2; ++b)
#pragma unroll
                for (int m = 0; m < 4; ++m)
#pragma unroll
                    for (int n = 0; n < 2; ++n) acc[a][b][m][n] = (f32x4){0.f, 0.f, 0.f, 0.f};
        cur = nxt; cA = nA; cB = nB; ++ui;
        if (wr == 1) PG8_BAR;
    }
    PG8_WAIT_V(0);
    PG8_BAR;
#undef PG8_SA
#undef PG8_SB
#undef PG8_STAGE
#undef PG8_LDA
#undef PG8_LDB
#undef PG8_MMA
#undef PG8_WAIT_V
#undef PG8_WAIT_L
#undef PG8_BAR
#undef PG8_SCHED
}
}
using pg8::Unit;
__device__ __forceinline__ size_t tiled_off(int row, int col, int nkt) {
    return ((size_t)(row >> 7) * nkt + (col >> 6)) * 16384 + (size_t)pg8::lds_byte(row & 127, col & 63);
}
__device__ __forceinline__ int invperm32(int w) { return 16 * ((w >> 2) & 1) + 4 * (w >> 3) + (w & 3); }
typedef f32x4 AccT[2][2][4][2];
__device__ __forceinline__ float row_rstd(const LAS float* RS, int ord, int lrow) {
    const float ssum = RS[ord * 256 + lrow] + RS[2048 + ord * 256 + lrow];
    return 1.0f / sqrtf(ssum * (1.0f / D) + 1e-6f);
}
__device__ __forceinline__ void stage_row_ss(LAS unsigned char* lds, const float* SS, const pg8::StaticOrder& S) {
    LAS float* RS = (LAS float*)(lds + LDS_RS);
    const int tid = otid(), wave = __builtin_amdgcn_readfirstlane(tid >> 6), lane = tid & 63;
    pg8::Unit u;
    if (S.next(wave, u)) {
        const float* sp = SS + u.pm * 256 + lane;
        float a[4];
#pragma unroll
        for (int j = 0; j < 4; ++j) a[j] = 0.f;
#pragma unroll
        for (int t = 0; t < 8; ++t)
#pragma unroll
            for (int j = 0; j < 4; ++j) a[j] += sp[(size_t)t * M + 64 * j];
#pragma unroll
        for (int j = 0; j < 4; ++j) { RS[wave * 256 + lane + 64 * j] = a[j]; RS[2048 + wave * 256 + lane + 64 * j] = 0.f; }
    }
    __syncthreads();
}
struct EpiSwiGLU {
    static constexpr bool PERM = true;
    bf16_t* H; const LAS float* RS;
    __device__ __forceinline__ void operator()(const AccT& acc, const Unit& u, int wr, int wc, int fr, int fq) const {
        const int row0 = u.pm * 256 + wr * 64 + fr, col0 = u.pn * 128 + wc * 32 + 8 * fq;
#pragma unroll
        for (int ai = 0; ai < 2; ++ai)
#pragma unroll
            for (int m = 0; m < 4; ++m) {
                const int row = row0 + ai * 128 + m * 16;
                const float rstd = row_rstd(RS, u.ord, wr * 64 + fr + ai * 128 + m * 16);
                bf16_t* rowp = H + (size_t)row * DFF + col0;
                float v[8];
#pragma unroll
                for (int n = 0; n < 2; ++n)
#pragma unroll
                    for (int e = 0; e < 4; ++e) v[4 * n + e] = siluf_(acc[ai][0][m][n][e] * rstd) * (acc[ai][1][m][n][e] * rstd);
                u32x4 w; w.x = pk2(v[0], v[1]); w.y = pk2(v[2], v[3]); w.z = pk2(v[4], v[5]); w.w = pk2(v[6], v[7]);
                *(u32x4*)((char*)H + tiled_off(row, col0, DFF / 64)) = w;
            }
    }
};
struct EpiResidual {
    static constexpr bool PERM = false;
    const float* src; float* dst; bf16_t* XB; float* SS; LAS float* RSW; float alpha;
    __device__ __forceinline__ void operator()(const AccT& acc, const Unit& u, int wr, int wc, int fr, int fq) const {
        const int row0 = u.pm * 256 + wr * 64 + fr, col0 = u.pn * 256 + wc * 32 + 4 * fq;
#pragma unroll
        for (int ai = 0; ai < 2; ++ai) {
            f32x4 xv[4][2][2];
#pragma unroll
            for (int m = 0; m < 4; ++m)
#pragma unroll
                for (int bj = 0; bj < 2; ++bj)
#pragma unroll
                    for (int n = 0; n < 2; ++n) xv[m][bj][n] = *(const f32x4*)(src + (size_t)(row0 + ai * 128 + m * 16) * D + col0 + bj * 128 + n * 16);
            __builtin_amdgcn_sched_barrier(0);
#pragma unroll
            for (int m = 0; m < 4; ++m) {
                const int row = row0 + ai * 128 + m * 16;
                const size_t ro = (size_t)row * D + col0;
                float ssq = 0.f;
#pragma unroll
                for (int bj = 0; bj < 2; ++bj)
#pragma unroll
                    for (int n = 0; n < 2; ++n) {
                        const f32x4 y = xv[m][bj][n] + alpha * acc[ai][bj][m][n];
                        *(f32x4*)(dst + ro + bj * 128 + n * 16) = y;
                        u32x2 w; w.x = pk2(y[0], y[1]); w.y = pk2(y[2], y[3]);
                        *(u32x2*)((char*)XB + tiled_off(row, col0 + bj * 128 + n * 16, D / 64)) = w;
                        ssq += (y[0] * y[0] + y[1] * y[1]) + (y[2] * y[2] + y[3] * y[3]);
                    }
                ssq += __shfl_xor(ssq, 16); ssq += __shfl_xor(ssq, 32);
                if (fq == 0) RSW[wc * 256 + (row & 255)] = ssq;
            }
            __builtin_amdgcn_sched_barrier(0);
        }
        __syncthreads();
        { const int t = wr * 256 + wc * 64 + fq * 16 + fr;
          if (t < 256) SS[(size_t)u.pn * M + u.pm * 256 + t] = (RSW[t] + RSW[256 + t]) + (RSW[512 + t] + RSW[768 + t]); }
        __syncthreads();
    }
};
struct EpiProj {
    static constexpr bool PERM = true;
    bf16_t* P; float* KMP; const float* rope; const LAS float* RS; bf16_t* GRL;
    __device__ __forceinline__ void operator()(const AccT& acc, const Unit& u, int wr, int wc, int fr, int fq) const {
        const int row0 = u.pm * 256 + wr * 64 + fr, col0 = u.pn * 256 + wc * 32 + 8 * fq;
        const int pn = u.pn;
        const bool rot = (pn < 8) || (pn >= 12 && pn < 20);
        const bool isgr = (pn >= 28 && pn < 36);
        if (!rot) {
#pragma unroll
            for (int ai = 0; ai < 2; ++ai)
#pragma unroll
                for (int m = 0; m < 4; ++m) {
                    const int row = row0 + ai * 128 + m * 16;
                    const float rstd = row_rstd(RS, u.ord, wr * 64 + fr + ai * 128 + m * 16);
                    bf16_t* rowp = P + (size_t)row * INW + col0;
#pragma unroll
                    for (int bj = 0; bj < 2; ++bj) {
                        const f32x4 v0 = acc[ai][bj][m][0] * rstd, v1 = acc[ai][bj][m][1] * rstd;
                        u32x4 w; w.x = pk2(v0[0], v0[1]); w.y = pk2(v0[2], v0[3]); w.z = pk2(v1[0], v1[1]); w.w = pk2(v1[2], v1[3]);
                        if (isgr) {
                            const int sp = row & (S - 1), tl = sp & 127;
                            bf16_t* gb = GRL + ((size_t)(((row >> 12) * 8 + (pn - 28)) * 32 + (sp >> 7))) * 32768
                                       + (size_t)((((((bj * 4 + wc) * 4 + fq) * 4 + (tl >> 5)) * 2) * 32 + (tl & 31)) * 4);
                            u32x2 lo2; lo2.x = w.x; lo2.y = w.y; u32x2 hi2; hi2.x = w.z; hi2.y = w.w;
                            *(u32x2*)gb = lo2; *(u32x2*)(gb + 32 * 4) = hi2;
                        } else *(u32x4*)(rowp + bj * 128) = w;
                    }
                }
            return;
        }
        const bool kindr = pn >= 12;
        const float* ctab = rope + (kindr ? 2 : 0) * (4096 * 64);
        const float* stab = ctab + 4096 * 64;
        const float sc = (pn >= 16 && pn < 20) ? 0.08838834764831845f : 1.0f;
        const bool kmean = (pn >= 4 && pn < 8);
        f32x4 cs[2][2];
#pragma unroll
        for (int bj = 0; bj < 2; ++bj)
#pragma unroll
            for (int n = 0; n < 2; ++n) cs[bj][n] = (f32x4){0.f, 0.f, 0.f, 0.f};
        f32x4 cv[2][4], sv[2][4];
#pragma unroll
        for (int ai = 0; ai < 2; ++ai)
#pragma unroll
            for (int m = 0; m < 4; ++m) {
                const int pos = (row0 + ai * 128 + m * 16) & (S - 1);
                cv[ai][m] = *(const f32x4*)(ctab + pos * 64 + wc * 16 + fq * 4);
                sv[ai][m] = *(const f32x4*)(stab + pos * 64 + wc * 16 + fq * 4);
            }
        __builtin_amdgcn_sched_barrier(0);
#pragma unroll
        for (int ai = 0; ai < 2; ++ai)
#pragma unroll
            for (int m = 0; m < 4; ++m) {
                const int row = row0 + ai * 128 + m * 16;
                const float rs = sc * row_rstd(RS, u.ord, wr * 64 + fr + ai * 128 + m * 16);
                const f32x4 c4 = cv[ai][m] * rs;
                const f32x4 s4 = sv[ai][m] * rs;
                bf16_t* rowp = P + (size_t)row * INW + col0;
#pragma unroll
                for (int bj = 0; bj < 2; ++bj) {
                    const f32x4 x1 = acc[ai][bj][m][0], x2 = acc[ai][bj][m][1];
                    const f32x4 o1 = x1 * c4 - x2 * s4, o2 = x1 * s4 + x2 * c4;
                    cs[bj][0] += o1; cs[bj][1] += o2;
                    u32x4 w; w.x = pk2(o1[0], o1[1]); w.y = pk2(o1[2], o1[3]); w.z = pk2(o2[0], o2[1]); w.w = pk2(o2[2], o2[3]);
                    *(u32x4*)(rowp + bj * 128) = w;
                }
            }
        if (kmean) {
#pragma unroll
            for (int bj = 0; bj < 2; ++bj)
#pragma unroll
                for (int n = 0; n < 2; ++n)
#pragma unroll
                    for (int e = 0; e < 4; ++e) {
                        float v = cs[bj][n][e];
                        v += __shfl_xor(v, 1); v += __shfl_xor(v, 2); v += __shfl_xor(v, 4); v += __shfl_xor(v, 8);
                        cs[bj][n][e] = v;
                    }
            if (fr == 0) {
                float* kp = KMP + ((size_t)wr * 32 + u.pm) * 1024 + (pn - 4) * 256 + wc * 32 + 8 * fq;
#pragma unroll
                for (int bj = 0; bj < 2; ++bj) { *(f32x4*)(kp + bj * 128) = cs[bj][0]; *(f32x4*)(kp + bj * 128 + 4) = cs[bj][1]; }
            }
        }
    }
};
struct EpiBranchB {
    static constexpr bool PERM = true;
    float* T1; const bf16_t* P;
    __device__ __forceinline__ void operator()(const AccT& acc, const Unit& u, int wr, int wc, int fr, int fq) const {
        const int row0 = u.pm * 256 + wr * 64 + fr, col0 = u.pn * 256 + wc * 32 + 8 * fq;
        u32x4 gv[2][4][2];
#pragma unroll
        for (int ai = 0; ai < 2; ++ai)
#pragma unroll
            for (int m = 0; m < 4; ++m)
#pragma unroll
                for (int bj = 0; bj < 2; ++bj) gv[ai][m][bj] = *(const u32x4*)(P + (size_t)(row0 + ai * 128 + m * 16) * INW + C_GB + col0 + bj * 128);
        __builtin_amdgcn_sched_barrier(0);
#pragma unroll
        for (int ai = 0; ai < 2; ++ai)
#pragma unroll
            for (int m = 0; m < 4; ++m) {
                const size_t row = (size_t)(row0 + ai * 128 + m * 16);
#pragma unroll
                for (int bj = 0; bj < 2; ++bj) {
                    const u32x4 g = gv[ai][m][bj];
                    f32x4 o0, o1;
                    o0[0] = sigmoidf_(bflo(g.x)) * acc[ai][bj][m][0][0]; o0[1] = sigmoidf_(bfhi(g.x)) * acc[ai][bj][m][0][1];
                    o0[2] = sigmoidf_(bflo(g.y)) * acc[ai][bj][m][0][2]; o0[3] = sigmoidf_(bfhi(g.y)) * acc[ai][bj][m][0][3];
                    o1[0] = sigmoidf_(bflo(g.z)) * acc[ai][bj][m][1][0]; o1[1] = sigmoidf_(bfhi(g.z)) * acc[ai][bj][m][1][1];
                    o1[2] = sigmoidf_(bflo(g.w)) * acc[ai][bj][m][1][2]; o1[3] = sigmoidf_(bfhi(g.w)) * acc[ai][bj][m][1][3];
                    float* tp = T1 + row * D + col0 + bj * 128;
                    *(f32x4*)tp = o0; *(f32x4*)(tp + 4) = o1;
                }
            }
    }
};
struct EpiBranchA {
    static constexpr bool PERM = true;
    const float* T1; const bf16_t* P; bf16_t* MG;
    __device__ __forceinline__ void operator()(const AccT& acc, const Unit& u, int wr, int wc, int fr, int fq) const {
        const int row0 = u.pm * 256 + wr * 64 + fr, col0 = u.pn * 256 + wc * 32 + 8 * fq;
#pragma unroll
        for (int ai = 0; ai < 2; ++ai)
#pragma unroll
            for (int mp = 0; mp < 2; ++mp) {
                u32x4 gv[2][2]; f32x4 tv[2][2][2];
#pragma unroll
                for (int mi = 0; mi < 2; ++mi)
#pragma unroll
                    for (int bj = 0; bj < 2; ++bj) {
                        const size_t row = (size_t)(row0 + ai * 128 + (2 * mp + mi) * 16);
                        gv[mi][bj] = *(const u32x4*)(P + row * INW + C_GA + col0 + bj * 128);
                        const float* tp = T1 + row * D + col0 + bj * 128;
                        tv[mi][bj][0] = *(const f32x4*)tp; tv[mi][bj][1] = *(const f32x4*)(tp + 4);
                    }
                __builtin_amdgcn_sched_barrier(0);
#pragma unroll
                for (int mi = 0; mi < 2; ++mi)
#pragma unroll
                    for (int bj = 0; bj < 2; ++bj) {
                        const int m = 2 * mp + mi;
                        const size_t row = (size_t)(row0 + ai * 128 + m * 16);
                        const u32x4 g = gv[mi][bj];
                        const f32x4 t0 = tv[mi][bj][0], t1 = tv[mi][bj][1];
                        float o[8];
                        o[0] = t0[0] + sigmoidf_(bflo(g.x)) * acc[ai][bj][m][0][0]; o[1] = t0[1] + sigmoidf_(bfhi(g.x)) * acc[ai][bj][m][0][1];
                        o[2] = t0[2] + sigmoidf_(bflo(g.y)) * acc[ai][bj][m][0][2]; o[3] = t0[3] + sigmoidf_(bfhi(g.y)) * acc[ai][bj][m][0][3];
                        o[4] = t1[0] + sigmoidf_(bflo(g.z)) * acc[ai][bj][m][1][0]; o[5] = t1[1] + sigmoidf_(bfhi(g.z)) * acc[ai][bj][m][1][1];
                        o[6] = t1[2] + sigmoidf_(bflo(g.w)) * acc[ai][bj][m][1][2]; o[7] = t1[3] + sigmoidf_(bfhi(g.w)) * acc[ai][bj][m][1][3];
                        u32x4 w; w.x = pk2(o[0], o[1]); w.y = pk2(o[2], o[3]); w.z = pk2(o[4], o[5]); w.w = pk2(o[6], o[7]);
                        *(u32x4*)((char*)MG + tiled_off((int)row, col0 + bj * 128, D / 64)) = w;
                    }
                __builtin_amdgcn_sched_barrier(0);
            }
    }
};

template <int MAP> __device__ __forceinline__ int rowmap(int n) {
    if (MAP == 1) return (n >> 7) * 256 + (n & 127);
    if (MAP == 2) return (n >> 7) * 256 + 128 + (n & 127);
    if (MAP == 3) {
        const bool rot = (n < 2048) || (n >= 3072 && n < 5120);
        if (!rot) return n;
        const int c = n & 127, i = c & 63, half = c >> 6;
        return (n & ~127) + 32 * (i >> 4) + 8 * ((i >> 2) & 3) + 4 * half + (i & 3);
    }
    return n;
}
template <int MAP, bool HASG, bool PERMW>
__device__ __forceinline__ void transpose_item(const float* W, int K, int N, bf16_t* WT, LAS float* scr, int item, int lane, const float* gk) {
    const int nblk = N / 32, kb = item / nblk, nb = item % nblk, k0 = 64 * kb, n0 = 32 * nb;
    { float wv[32];
#pragma unroll
      for (int i = 0; i < 32; ++i) { const int kk = 2 * i + (lane >> 5); wv[i] = __builtin_nontemporal_load(W + (size_t)(k0 + kk) * N + n0 + (lane & 31)); }
      __builtin_amdgcn_sched_barrier(0);
#pragma unroll
      for (int i = 0; i < 32; ++i) { const int kk = 2 * i + (lane >> 5); scr[kk * 33 + (lane & 31)] = wv[i]; } }
    asm volatile("s_waitcnt lgkmcnt(0)" ::: "memory");
    const int c = lane & 7;
    f32x4 g0 = {1.f, 1.f, 1.f, 1.f}, g1 = {1.f, 1.f, 1.f, 1.f};
    if (HASG) { g0 = *(const f32x4*)(gk + k0 + 8 * c); g1 = *(const f32x4*)(gk + k0 + 8 * c + 4); }
#pragma unroll
    for (int j = 0; j < 4; ++j) { const int n = (lane >> 3) + 8 * j; const LAS float* s = scr + (8 * c) * 33 + n;
        u32x4 o; o.x = pk2(s[0 * 33] * g0[0], s[1 * 33] * g0[1]); o.y = pk2(s[2 * 33] * g0[2], s[3 * 33] * g0[3]); o.z = pk2(s[4 * 33] * g1[0], s[5 * 33] * g1[1]); o.w = pk2(s[6 * 33] * g1[2], s[7 * 33] * g1[3]);
        const int wr_ = rowmap<MAP>(n0 + n), slot_ = PERMW ? ((wr_ & ~31) + invperm32(wr_ & 31)) : wr_;
        *(u32x4*)((char*)WT + tiled_off(slot_, k0 + 8 * c, K / 64)) = o; }
    asm volatile("s_waitcnt lgkmcnt(0)" ::: "memory");
}
template <int MAP, bool HASG = false, bool PERMW = false>
__device__ __forceinline__ void transpose_mat(const float* W, int K, int N, bf16_t* WT, LAS float* scr, int gw, int ngw, int lane, const float* gk = nullptr) {
    const int nitems = (K / 64) * (N / 32);
    for (int it = gw; it < nitems; it += ngw) transpose_item<MAP, HASG, PERMW>(W, K, N, WT, scr, it, lane, gk);
}

template <bool F32OUT>
__device__ __forceinline__ void rms_row(const float* xrow, const float* g, void* orow, int lane) {
    const f32x4* xr = (const f32x4*)xrow + lane;
    f32x4 v[8]; float s = 0.f;
#pragma unroll
    for (int j = 0; j < 8; ++j) { v[j] = xr[64 * j]; s += (v[j].x * v[j].x + v[j].y * v[j].y) + (v[j].z * v[j].z + v[j].w * v[j].w); }
    const float rstd = 1.0f / sqrtf(wave_sum(s) * (1.0f / D) + 1e-6f);
    const f32x4* gr = (const f32x4*)g + lane;
#pragma unroll
    for (int j = 0; j < 8; ++j) {
        const f32x4 gg = gr[64 * j];
        const f32x4 o = v[j] * rstd * gg;
        if (F32OUT) ((f32x4*)orow)[lane + 64 * j] = o;
        else { u32x2 w; w.x = pk2(o.x, o.y); w.y = pk2(o.z, o.w); ((u32x2*)orow)[lane + 64 * j] = w; }
    }
}

constexpr int MB_K = 0, MB_KS = 272, MB_V = 34816, MB_VS = 320, MB_BUF = 75776, MB_KM = 75776, MB_G = 83968, MB_SEL = 92160, MB_ML = 65536, MB_OB = 0;
__device__ __forceinline__ void moba_item(const Params& p, LAS unsigned char* lds, int b, int h, int qb, int half) {
    unsigned char* wsb = opq_ptr(p.ws);
    const bf16_t* PROJ = (const bf16_t*)(wsb + WS_PROJ);
    const float* KMP = (const float*)(wsb + WS_KMP);
    bf16_t* Y = (bf16_t*)(wsb + WS_Y);
    const int tid = otid(), wave = __builtin_amdgcn_readfirstlane(tid >> 6), lane = tid & 63, r = lane & 31, hh = lane >> 5;
    const int wq = wave & 3, team = wave >> 2;
    const int q4 = (lane & 15) >> 2, p4 = lane & 3, b16 = (lane >> 4) & 1;
    const size_t tok0 = (size_t)b * S + qb * 256 + half * 128;
    LAS unsigned char* Kl = lds + MB_K; LAS unsigned char* Vl = lds + MB_V;
    LAS float* KM = (LAS float*)(lds + MB_KM); LAS float* G = (LAS float*)(lds + MB_G); LAS unsigned* SEL = (LAS unsigned*)(lds + MB_SEL);
    LAS float* ML = (LAS float*)(lds + MB_ML); LAS float* OB = (LAS float*)(lds + MB_OB);
    __syncthreads();
    unsigned mymask;
    if (qb > 3) {
        { const int j = tid >> 5, d = (tid & 31) * 4;
          if (j < qb) { const size_t o = ((size_t)(b * 16 + j)) * 1024 + h * 128 + d;
              const f32x4 a = *(const f32x4*)(KMP + o), c = *(const f32x4*)(KMP + 32 * 1024 + o);
              *(LAS f32x4*)(KM + j * 128 + d) = a + c; } }
        __syncthreads();
        { const int qi = tid >> 2, part = tid & 3;
          const u32x4* qp = (const u32x4*)(PROJ + (tok0 + qi) * INW + C_QA + h * 128 + part * 32);
          float qv[32];
#pragma unroll
          for (int c = 0; c < 4; ++c) { const u32x4 t = qp[c];
              qv[8 * c + 0] = bflo(t.x); qv[8 * c + 1] = bfhi(t.x); qv[8 * c + 2] = bflo(t.y); qv[8 * c + 3] = bfhi(t.y);
              qv[8 * c + 4] = bflo(t.z); qv[8 * c + 5] = bfhi(t.z); qv[8 * c + 6] = bflo(t.w); qv[8 * c + 7] = bfhi(t.w); }
          for (int j = 0; j < qb; ++j) {
              const LAS f32x4* km = (const LAS f32x4*)(KM + j * 128 + part * 32);
              float s = 0.f;
#pragma unroll
              for (int c = 0; c < 8; ++c) { const f32x4 k4 = km[c]; s += qv[4 * c] * k4.x + qv[4 * c + 1] * k4.y + qv[4 * c + 2] * k4.z + qv[4 * c + 3] * k4.w; }
              s += __shfl_xor(s, 1); s += __shfl_xor(s, 2);
              if (part == 0) G[qi * 16 + j] = s;
          } }
        __syncthreads();
        if (tid < 128) {
            unsigned mask = 0;
            for (int t = 0; t < 3; ++t) {
                float best = -INFINITY; int bi = 0;
                for (int j = 0; j < qb; ++j) { const float g = G[tid * 16 + j]; const bool ok = !((mask >> j) & 1u) && (g > best); if (ok) { best = g; bi = j; } }
                mask |= 1u << bi;
            }
            SEL[tid] = mask;
        }
        __syncthreads();
        mymask = SEL[32 * wq + r];
    } else mymask = (1u << qb) - 1u;

    bf16x8 qf[8];
    { const bf16_t* qrow = PROJ + (tok0 + 32 * wq + r) * INW + C_QA + h * 128 + 8 * hh;
#pragma unroll
      for (int ks = 0; ks < 8; ++ks) qf[ks] = *(const bf16x8*)(qrow + 16 * ks); }
    f32x16 O[4];
#pragma unroll
    for (int dt = 0; dt < 4; ++dt)
#pragma unroll
        for (int i = 0; i < 16; ++i) O[dt][i] = 0.f;
    float m_run = -1e30f, l_run = 0.f;
    const int nsteps = 2 * (qb + 1);
    const int qloc = 128 * half + 32 * wq + r;
    const float SC = 0.08838834764831845f * 1.4426950408889634f;
    u32x4 kreg[4], vreg[4];
    const int srow = tid >> 4, scol = tid & 15;
#define MOBA_ISSUE_K(step_) do { const int jj_ = (step_) >> 1, blk_ = jj_ == 0 ? qb : jj_ - 1; const int key0_ = blk_ * 256 + ((step_) & 1) * 128; \
        _Pragma("unroll") for (int i_ = 0; i_ < 4; ++i_) { const bf16_t* src_ = PROJ + ((size_t)b * S + key0_ + srow + 32 * i_) * INW + h * 128 + scol * 8; \
            kreg[i_] = *(const u32x4*)(src_ + C_KA); } } while (0)
#define MOBA_ISSUE_V(step_) do { const int jj_ = (step_) >> 1, blk_ = jj_ == 0 ? qb : jj_ - 1; const int key0_ = blk_ * 256 + ((step_) & 1) * 128; \
        _Pragma("unroll") for (int i_ = 0; i_ < 4; ++i_) { const bf16_t* src_ = PROJ + ((size_t)b * S + key0_ + srow + 32 * i_) * INW + h * 128 + scol * 8; \
            vreg[i_] = *(const u32x4*)(src_ + C_VA); } } while (0)
    MOBA_ISSUE_K(0); MOBA_ISSUE_V(0);
#pragma unroll
    for (int i = 0; i < 4; ++i) { *(LAS u32x4*)(Kl + (srow + 32 * i) * MB_KS + scol * 16) = kreg[i]; *(LAS u32x4*)(Vl + (srow + 32 * i) * MB_VS + scol * 16) = vreg[i]; }
    if (nsteps > 1) { MOBA_ISSUE_K(1); MOBA_ISSUE_V(1); }
    for (int step = 0; step < nsteps; ++step) {
        __syncthreads();
        const int cb = (step & 1) * MB_BUF;
        if (step + 1 < nsteps) {
            const int nb = MB_BUF - cb;
#pragma unroll
            for (int i = 0; i < 4; ++i) { *(LAS u32x4*)(Kl + nb + (srow + 32 * i) * MB_KS + scol * 16) = kreg[i]; *(LAS u32x4*)(Vl + nb + (srow + 32 * i) * MB_VS + scol * 16) = vreg[i]; }
            if (step + 2 < nsteps) { MOBA_ISSUE_K(step + 2); MOBA_ISSUE_V(step + 2); }
        }
        const int jj = step >> 1, blk = jj == 0 ? qb : jj - 1;
        const bool own = jj == 0;
        const bool sel = own || ((mymask >> blk) & 1u);
        f32x16 s[2];
#pragma unroll
        for (int kt = 0; kt < 2; ++kt) {
            bf16x8 af[8];
#pragma unroll
            for (int ks = 0; ks < 8; ++ks) af[ks] = *(const LAS bf16x8*)(Kl + cb + (64 * team + 32 * kt + r) * MB_KS + (16 * ks + 8 * hh) * 2);
            __builtin_amdgcn_sched_barrier(0);
#pragma unroll
            for (int i = 0; i < 16; ++i) s[kt][i] = 0.f;
#pragma unroll
            for (int ks = 0; ks < 8; ++ks) s[kt] = MFMA32(af[ks], qf[ks], s[kt]);
            __builtin_amdgcn_sched_barrier(0);
        }
        float tmax = -INFINITY;
        const int kbase = (step & 1) * 128 + 64 * team;
        if (own) {
            asm volatile("" ::: "memory");
#pragma unroll
            for (int kt = 0; kt < 2; ++kt)
#pragma unroll
                for (int i = 0; i < 16; ++i) {
                    const int kl = kbase + 32 * kt + crow(i, hh);
                    const float v = (kl <= qloc) ? s[kt][i] : -INFINITY;
                    s[kt][i] = v; tmax = fmaxf(tmax, v);
                }
        } else {
            asm volatile("" ::: "memory");
#pragma unroll
            for (int kt = 0; kt < 2; ++kt)
#pragma unroll
                for (int i = 0; i < 16; ++i) tmax = fmaxf(tmax, s[kt][i]);
            tmax = sel ? tmax : -INFINITY;
        }
        tmax = fmaxf(tmax, __shfl_xor(tmax, 32)) * SC;
        const float m_new = fmaxf(m_run, tmax);
        const float alpha = __builtin_amdgcn_exp2f(m_run - m_new);
        const float msub = sel ? m_new : INFINITY;
        float psum = 0.f;
#pragma unroll
        for (int kt = 0; kt < 2; ++kt)
#pragma unroll
            for (int i = 0; i < 16; ++i) { const float pv = __builtin_amdgcn_exp2f(__builtin_fmaf(s[kt][i], SC, -msub)); s[kt][i] = pv; psum += pv; }
        psum += __shfl_xor(psum, 32);
        l_run = l_run * alpha + psum; m_run = m_new;
        {
#pragma unroll
            for (int dt = 0; dt < 4; ++dt)
#pragma unroll
                for (int i = 0; i < 16; ++i) O[dt][i] *= alpha;
        }
#pragma unroll
        for (int kt = 0; kt < 2; ++kt) {
            bf16x8 vf0[4], vf1[4];
#pragma unroll
            for (int dt = 0; dt < 4; ++dt) {
                vf0[dt] = tr_read2(Vl + cb + (64 * team + 32 * kt + 4 * hh + q4) * MB_VS + (32 * dt + 16 * b16 + 4 * p4) * 2, 8 * MB_VS);
                vf1[dt] = tr_read2(Vl + cb + (64 * team + 32 * kt + 16 + 4 * hh + q4) * MB_VS + (32 * dt + 16 * b16 + 4 * p4) * 2, 8 * MB_VS);
            }
            const bf16x8 pf0 = pack_step<0>(s[kt]), pf1 = pack_step<1>(s[kt]);
            __builtin_amdgcn_sched_barrier(0);
#pragma unroll
            for (int dt = 0; dt < 4; ++dt) O[dt] = MFMA32(vf0[dt], pf0, O[dt]);
#pragma unroll
            for (int dt = 0; dt < 4; ++dt) O[dt] = MFMA32(vf1[dt], pf1, O[dt]);
            __builtin_amdgcn_sched_barrier(0);
        }
    }
#undef MOBA_ISSUE_K
#undef MOBA_ISSUE_V
    __syncthreads();
    if (team == 1) {
#pragma unroll
        for (int dt = 0; dt < 4; ++dt)
#pragma unroll
            for (int i = 0; i < 16; ++i) OB[((wq * 4 + dt) * 16 + i) * 64 + lane] = O[dt][i];
        ML[(wq * 64 + lane) * 2] = m_run; ML[(wq * 64 + lane) * 2 + 1] = l_run;
    }
    __syncthreads();
    if (team == 0) {
        const float mB = ML[(wq * 64 + lane) * 2], lB = ML[(wq * 64 + lane) * 2 + 1];
        const float mm = fmaxf(m_run, mB), a = __builtin_amdgcn_exp2f(m_run - mm), bsc = __builtin_amdgcn_exp2f(mB - mm);
        const float inv = 1.0f / (l_run * a + lB * bsc);
        const float a2 = a * inv, b2 = bsc * inv;
        bf16_t* yrow = Y + (tok0 + 32 * wq + r) * 1024 + h * 128 + 4 * hh;
#pragma unroll
        for (int dt = 0; dt < 4; ++dt)
#pragma unroll
            for (int g4 = 0; g4 < 4; ++g4) {
                float o[4];
#pragma unroll
                for (int e = 0; e < 4; ++e) o[e] = O[dt][4 * g4 + e] * a2 + OB[((wq * 4 + dt) * 16 + 4 * g4 + e) * 64 + lane] * b2;
                u32x2 w; w.x = pk2(o[0], o[1]); w.y = pk2(o[2], o[3]);
                *(u32x2*)((char*)Y + tiled_off((int)(tok0 + 32 * wq + r), h * 128 + 4 * hh + 32 * dt + 8 * g4, 1024 / 64)) = w;
            }
    }
}

__device__ __forceinline__ float ret_log2g(int h) { const double g = 1.0 - ldexp(1.0, -(5 + h)); return (float)log2(g); }
constexpr int RK_K = 0, RK_KS = 320, RK_V = 40960, RK_VS = 576;
__device__ __forceinline__ void ret_kv_item(const Params& p, LAS unsigned char* lds, int b, int h, int n) {
    unsigned char* wsb = opq_ptr(p.ws);
    const bf16_t* PROJ = (const bf16_t*)(wsb + WS_PROJ);
    float* KV = (float*)(wsb + WS_HID);
    const int tid = otid(), wave = __builtin_amdgcn_readfirstlane(tid >> 6), lane = tid & 63, r = lane & 31, hh = lane >> 5;
    const int q4 = (lane & 15) >> 2, p4 = lane & 3, b16 = (lane >> 4) & 1;
    const size_t tok0 = (size_t)b * S + n * 128;
    const float lg2 = ret_log2g(h);
    LAS unsigned char* Kl = lds + RK_K; LAS unsigned char* Vl = lds + RK_V;
    __syncthreads();
    u32x4 kin[4], vin[8];
#pragma unroll
    for (int i = 0; i < 4; ++i) { const int c = tid + 512 * i, row = c >> 4, cc = c & 15; kin[i] = *(const u32x4*)(PROJ + (tok0 + row) * INW + C_KR + h * 128 + cc * 8); }
#pragma unroll
    for (int i = 0; i < 8; ++i) { const int c = tid + 512 * i, row = c >> 5, cc = c & 31; vin[i] = *(const u32x4*)(PROJ + (tok0 + row) * INW + C_VR + h * 256 + cc * 8); }
    __builtin_amdgcn_sched_barrier(0);
#pragma unroll
    for (int i = 0; i < 4; ++i) {
        const int c = tid + 512 * i, row = c >> 4, cc = c & 15;
        const u32x4 t = kin[i];
        const float z = __builtin_amdgcn_exp2f((float)(127 - row) * lg2);
        u32x4 o; o.x = pk2(bflo(t.x) * z, bfhi(t.x) * z); o.y = pk2(bflo(t.y) * z, bfhi(t.y) * z); o.z = pk2(bflo(t.z) * z, bfhi(t.z) * z); o.w = pk2(bflo(t.w) * z, bfhi(t.w) * z);
        *(LAS u32x4*)(Kl + row * RK_KS + cc * 16) = o;
    }
#pragma unroll
    for (int i = 0; i < 8; ++i) {
        const int c = tid + 512 * i, row = c >> 5, cc = c & 31;
        *(LAS u32x4*)(Vl + row * RK_VS + cc * 16) = vin[i];
    }
    __syncthreads();
    f32x16 acc[4];
#pragma unroll
    for (int dt = 0; dt < 4; ++dt)
#pragma unroll
        for (int i = 0; i < 16; ++i) acc[dt][i] = 0.f;
#pragma unroll
    for (int ks = 0; ks < 8; ++ks) {
        const int m0 = 16 * ks + 8 * hh + q4;
        const bf16x8 af = tr_read2(Vl + m0 * RK_VS + (32 * wave + 16 * b16 + 4 * p4) * 2, 4 * RK_VS);
        bf16x8 bfr[4];
#pragma unroll
        for (int dt = 0; dt < 4; ++dt) bfr[dt] = tr_read2(Kl + m0 * RK_KS + (32 * dt + 16 * b16 + 4 * p4) * 2, 4 * RK_KS);
        if (ks & 1) __builtin_amdgcn_sched_barrier(0);
#pragma unroll
        for (int dt = 0; dt < 4; ++dt) acc[dt] = MFMA32(af, bfr[dt], acc[dt]);
    }
    float* kvp = KV + ((size_t)((b * 8 + h) * 32 + n)) * (256 * 128);
#pragma unroll
    for (int dt = 0; dt < 4; ++dt)
#pragma unroll
        for (int i = 0; i < 16; ++i) kvp[(32 * wave + crow(i, hh)) * 128 + 32 * dt + r] = acc[dt][i];
}

constexpr int RO_K = 0, RO_KS = 272, RO_V = 34816, RO_VS = 576, RO_STAT = 108544;
__device__ __forceinline__ void ret_out_item(const Params& p, LAS unsigned char* lds, int b, int h, int n) {
    unsigned char* wsb = opq_ptr(p.ws);
    const bf16_t* PROJ = (const bf16_t*)(wsb + WS_PROJ);
    const bf16_t* PREVT = (const bf16_t*)(wsb + WS_XN);
    bf16_t* Y = (bf16_t*)(wsb + WS_YR);
    const int tid = otid(), wave = __builtin_amdgcn_readfirstlane(tid >> 6), lane = tid & 63, r = lane & 31, hh = lane >> 5;
    const int q4 = (lane & 15) >> 2, p4 = lane & 3, b16 = (lane >> 4) & 1;
    const int cq = wave & 3, eh = wave >> 2;
    const size_t tok0 = (size_t)b * S + n * 128;
    const float lg2 = ret_log2g(h);
    LAS unsigned char* Kl = lds + RO_K; LAS unsigned char* Vl = lds + RO_V; LAS float* STAT = (LAS float*)(lds + RO_STAT);
    __syncthreads();
    bf16x8 qf[8];
    { const bf16_t* qrow = PROJ + (tok0 + 32 * cq + r) * INW + C_QR + h * 128 + 8 * hh;
#pragma unroll
      for (int ks = 0; ks < 8; ++ks) qf[ks] = *(const bf16x8*)(qrow + 16 * ks); }
    bf16x8 pfr[4][8];
    { const bf16_t* pv = PREVT + ((size_t)((b * 8 + h) * 32 + n)) * (256 * 128) + (size_t)(eh * 32 * 64 + lane) * 8;
#pragma unroll
      for (int et = 0; et < 4; ++et)
#pragma unroll
          for (int ks = 0; ks < 8; ++ks) pfr[et][ks] = *(const bf16x8*)(pv + (size_t)((et * 8 + ks) * 64) * 8); }
    { u32x4 kin[4], vin[4];
#pragma unroll
      for (int i = 0; i < 4; ++i) { const int c = tid + 512 * i, row = c >> 4, cc = c & 15; kin[i] = *(const u32x4*)(PROJ + (tok0 + row) * INW + C_KR + h * 128 + cc * 8); }
#pragma unroll
      for (int i = 0; i < 4; ++i) { const int c = tid + 512 * i, row = c >> 5, cc = c & 31; vin[i] = *(const u32x4*)(PROJ + (tok0 + row) * INW + C_VR + h * 256 + cc * 8); }
      __builtin_amdgcn_sched_barrier(0);
#pragma unroll
      for (int i = 0; i < 4; ++i) { const int c = tid + 512 * i, row = c >> 4, cc = c & 15; *(LAS u32x4*)(Kl + row * RO_KS + cc * 16) = kin[i]; }
#pragma unroll
      for (int i = 0; i < 4; ++i) { const int c = tid + 512 * i, row = c >> 5, cc = c & 31; *(LAS u32x4*)(Vl + row * RO_VS + cc * 16) = vin[i]; }
      __builtin_amdgcn_sched_barrier(0);
#pragma unroll
      for (int i = 0; i < 4; ++i) { const int c = tid + 512 * (i + 4), row = c >> 5, cc = c & 31; vin[i] = *(const u32x4*)(PROJ + (tok0 + row) * INW + C_VR + h * 256 + cc * 8); }
      __builtin_amdgcn_sched_barrier(0);
#pragma unroll
      for (int i = 0; i < 4; ++i) { const int c = tid + 512 * (i + 4), row = c >> 5, cc = c & 31; *(LAS u32x4*)(Vl + row * RO_VS + cc * 16) = vin[i]; }
    }
    f32x16 acc[4];
#pragma unroll
    for (int et = 0; et < 4; ++et)
#pragma unroll
        for (int i = 0; i < 16; ++i) acc[et][i] = 0.f;
#pragma unroll
    for (int et = 0; et < 4; ++et)
#pragma unroll
        for (int ks = 0; ks < 8; ++ks) acc[et] = MFMA32(pfr[et][ks], qf[ks], acc[et]);
    const int cloc = 32 * cq + r;
    { const float xi = __builtin_amdgcn_exp2f((float)(cloc + 1) * lg2);
#pragma unroll
      for (int et = 0; et < 4; ++et)
#pragma unroll
          for (int i = 0; i < 16; ++i) acc[et][i] *= xi; }
    __syncthreads();
    for (int kt = 0; kt <= cq; ++kt) {
        f32x16 s;
#pragma unroll
        for (int i = 0; i < 16; ++i) s[i] = 0.f;
        { bf16x8 af[8];
#pragma unroll
          for (int ks = 0; ks < 8; ++ks) af[ks] = *(const LAS bf16x8*)(Kl + (32 * kt + r) * RO_KS + (16 * ks + 8 * hh) * 2);
          __builtin_amdgcn_sched_barrier(0);
#pragma unroll
          for (int ks = 0; ks < 8; ++ks) s = MFMA32(af[ks], qf[ks], s);
          __builtin_amdgcn_sched_barrier(0); }
#pragma unroll
        for (int i = 0; i < 16; ++i) {
            const int diff = cloc - (32 * kt + crow(i, hh));
            s[i] = diff >= 0 ? s[i] * __builtin_amdgcn_exp2f((float)diff * lg2) : 0.f;
        }
        { bf16x8 vf0[4], vf1[4];
#pragma unroll
          for (int et = 0; et < 4; ++et) {
              vf0[et] = tr_read2(Vl + (32 * kt + 4 * hh + q4) * RO_VS + (128 * eh + 32 * et + 16 * b16 + 4 * p4) * 2, 8 * RO_VS);
              vf1[et] = tr_read2(Vl + (32 * kt + 16 + 4 * hh + q4) * RO_VS + (128 * eh + 32 * et + 16 * b16 + 4 * p4) * 2, 8 * RO_VS); }
          const bf16x8 pf0 = pack_step<0>(s), pf1 = pack_step<1>(s);
          __builtin_amdgcn_sched_barrier(0);
#pragma unroll
          for (int et = 0; et < 4; ++et) acc[et] = MFMA32(vf0[et], pf0, acc[et]);
#pragma unroll
          for (int et = 0; et < 4; ++et) acc[et] = MFMA32(vf1[et], pf1, acc[et]);
          __builtin_amdgcn_sched_barrier(0); }
    }
    float sm = 0.f, sq = 0.f;
#pragma unroll
    for (int et = 0; et < 4; ++et)
#pragma unroll
        for (int i = 0; i < 16; ++i) { sm += acc[et][i]; sq += acc[et][i] * acc[et][i]; }
    sm += __shfl_xor(sm, 32); sq += __shfl_xor(sq, 32);
    if (hh == 0) { STAT[(eh * 128 + cloc) * 2] = sm; STAT[(eh * 128 + cloc) * 2 + 1] = sq; }
    __syncthreads();
    { const float osm = STAT[((eh ^ 1) * 128 + cloc) * 2], osq = STAT[((eh ^ 1) * 128 + cloc) * 2 + 1];
      sm += osm; sq += osq; }
    const float mu = sm * (1.0f / 256.0f);
    const float var = fmaxf(sq * (1.0f / 256.0f) - mu * mu, 0.f);
    const float rstd = 1.0f / sqrtf(var + 1e-6f);
    const size_t tok = tok0 + cloc;
    const bf16_t* grow = (const bf16_t*)(wsb + WS_GRL) + ((size_t)((b * 8 + h) * 32 + n)) * 32768 + (size_t)(((eh * 16 * 4 + cq) * 2 + hh) * 32 + r) * 4;
    bf16_t* yrow = Y + tok * 2048 + h * 256 + 128 * eh + 4 * hh;
    u32x2 gq[4][4];
#pragma unroll
    for (int et = 0; et < 4; ++et)
#pragma unroll
        for (int g4 = 0; g4 < 4; ++g4) gq[et][g4] = *(const u32x2*)(grow + (size_t)((et * 4 + g4) * 4 * 2 * 32 * 4));
    __builtin_amdgcn_sched_barrier(0);
#pragma unroll
    for (int et = 0; et < 4; ++et)
#pragma unroll
        for (int g4 = 0; g4 < 4; ++g4) {
            const u32x2 g = gq[et][g4];
            const float o0 = (acc[et][4 * g4 + 0] - mu) * rstd * siluf_(bflo(g.x));
            const float o1 = (acc[et][4 * g4 + 1] - mu) * rstd * siluf_(bfhi(g.x));
            const float o2 = (acc[et][4 * g4 + 2] - mu) * rstd * siluf_(bflo(g.y));
            const float o3 = (acc[et][4 * g4 + 3] - mu) * rstd * siluf_(bfhi(g.y));
            u32x2 w; w.x = pk2(o0, o1); w.y = pk2(o2, o3);
            *(u32x2*)((char*)Y + tiled_off((int)tok, h * 256 + 128 * eh + 4 * hh + 32 * et + 8 * g4, 2048 / 64)) = w;
        }
}

__global__ void __launch_bounds__(512, 2) mega_fwd(Params p) {
    extern __shared__ __attribute__((aligned(16))) unsigned char smem[];
    LAS unsigned char* lds = (LAS unsigned char*)smem;
    cg::grid_group grid = cg::this_grid();
#define PHASE_IDS const int tid = otid(), wave = __builtin_amdgcn_readfirstlane(tid >> 6), lane = tid & 63, gw = blockIdx.x * 8 + wave; (void)lane; (void)gw
#define PHASE_ENV unsigned char* ws = opq_ptr(p.ws); const int G = opq_int((int)gridDim.x), ngw = G * 8; (void)ws; (void)ngw
#define P_X ((float*)(ws + WS_X))
#define P_XB ((bf16_t*)(ws + WS_XB))
#define P_SS ((float*)(ws + WS_SS))
#define P_HID ((bf16_t*)(ws + WS_HID))
#define P_PROJ ((bf16_t*)(ws + WS_PROJ))
#define P_Y ((bf16_t*)(ws + WS_Y))
#define P_YR ((bf16_t*)(ws + WS_YR))
#define P_KMP ((float*)(ws + WS_KMP))
#define P_ROPE ((float*)(ws + WS_ROPE))
#define P_T1 ((float*)(ws + WS_HID))
#define P_KV ((float*)(ws + WS_HID))
#define P_PREVT ((bf16_t*)(ws + WS_XN))
#define P_MG ((bf16_t*)(ws + WS_XN))
#define P_W(off) ((bf16_t*)(ws + (off)))
    { volatile LAS unsigned* st0 = (volatile LAS unsigned*)(lds + LDS_BYTES - 16);
      if (threadIdx.x < 4) st0[threadIdx.x] = 0u;
      __syncthreads(); }
    xcd_barrier_post((unsigned*)(p.ws + WS_CTL));
    int nsync = 0;
#define GSYNC do { xcd_barrier(p.ws, (volatile LAS unsigned*)(lds + LDS_BYTES - 16)); ++nsync; } while (0)
    if (p.out == nullptr) grid.sync();

    { PHASE_IDS; PHASE_ENV;
    float* ROPE = P_ROPE;
    for (int idx = blockIdx.x * 512 + tid; idx < 2 * 4096 * 64; idx += G * 512) {
        const int kind = idx >> 18, pos = (idx >> 6) & 4095, i = idx & 63;
        const double ex = kind ? (double)i / 63.0 : (double)i / 64.0;
        const float invf = (float)exp(-ex * 9.210340371976184);
        const float ang = (float)pos * invf;
        const double rev = (double)ang * 0.15915494309189535;
        const float fr = (float)(rev - floor(rev));
        ROPE[(kind * 2 + 0) * (4096 * 64) + pos * 64 + i] = __builtin_amdgcn_cosf(fr);
        ROPE[(kind * 2 + 1) * (4096 * 64) + pos * 64 + i] = __builtin_amdgcn_sinf(fr);
    } }

    for (int l = 0; l < DEPTH; ++l) {
        {
            PHASE_IDS; PHASE_ENV;
            LAS float* scr = (LAS float*)(lds + wave * 8448);
            transpose_mat<1, true, true>(p.in[2] + (size_t)l * D * DFF, D, DFF, P_W(WS_WGU1), scr, gw, ngw, lane, p.in[1] + l * D);
            transpose_mat<2, true, true>(p.in[3] + (size_t)l * D * DFF, D, DFF, P_W(WS_WGU1), scr, gw, ngw, lane, p.in[1] + l * D);
            transpose_mat<0>(p.in[4] + (size_t)l * DFF * D, DFF, D, P_W(WS_WD1), scr, gw, ngw, lane);
            transpose_mat<3, true, true>(p.in[6] + (size_t)l * D * INW, D, INW, P_W(WS_WIN), scr, gw, ngw, lane, p.in[5] + l * D);
            transpose_mat<0, false, true>(p.in[7] + (size_t)l * 1024 * D, 1024, D, P_W(WS_WA), scr, gw, ngw, lane);
            transpose_mat<0, false, true>(p.in[8] + (size_t)l * 2048 * D, 2048, D, P_W(WS_WB), scr, gw, ngw, lane);
            transpose_mat<0>(p.in[9] + (size_t)l * D * D, D, D, P_W(WS_WO), scr, gw, ngw, lane);
            transpose_mat<1, true, true>(p.in[11] + (size_t)l * D * DFF, D, DFF, P_W(WS_WGU2), scr, gw, ngw, lane, p.in[10] + l * D);
            transpose_mat<2, true, true>(p.in[12] + (size_t)l * D * DFF, D, DFF, P_W(WS_WGU2), scr, gw, ngw, lane, p.in[10] + l * D);
            transpose_mat<0>(p.in[13] + (size_t)l * DFF * D, DFF, D, P_W(WS_WD2), scr, gw, ngw, lane);
            if (l == 0) {
                float* SSB = P_SS; bf16_t* XB = P_XB; const float* xin = p.in[0];
                for (int m = gw; m < M; m += ngw) {
                    const f32x4* xr = (const f32x4*)(xin + (size_t)m * D) + lane; float sq = 0.f;
                    f32x4 xv8[8];
#pragma unroll
                    for (int j = 0; j < 8; ++j) xv8[j] = xr[64 * j];
                    __builtin_amdgcn_sched_barrier(0);
#pragma unroll
                    for (int j = 0; j < 8; ++j) { const f32x4 v = xv8[j]; sq += (v.x * v.x + v.y * v.y) + (v.z * v.z + v.w * v.w);
                        u32x2 w; w.x = pk2(v.x, v.y); w.y = pk2(v.z, v.w); *(u32x2*)((char*)XB + tiled_off(m, 4 * (lane + 64 * j), D / 64)) = w; }
                    sq = wave_sum(sq);
                    if (lane < 8) SSB[(size_t)lane * M + m] = (lane == 0) ? sq : 0.f;
                }
            }
        }
        GSYNC;
        { PHASE_ENV; pg8::StaticOrder SO; pg8::Gemm g{P_XB, P_W(WS_WGU1), M, 2 * DFF, D}; SO.init(M, 2 * DFF, G, blockIdx.x); stage_row_ss(lds, P_SS + (size_t)(3 * l) * 8 * M, SO); EpiSwiGLU E{P_HID, (const LAS float*)(lds + LDS_RS)}; pg8::gemm_phase(lds, g, SO, E); }
        GSYNC;
        { PHASE_ENV; pg8::StaticOrder SO; pg8::Gemm g{P_HID, P_W(WS_WD1), M, D, DFF}; SO.init(M, D, G, blockIdx.x); EpiResidual E{(l == 0) ? p.in[0] : P_X, P_X, P_XB, P_SS + (size_t)(3 * l + 1) * 8 * M, (LAS float*)(lds + LDS_RS), 0.5f}; pg8::gemm_phase(lds, g, SO, E); }
        GSYNC;
        { PHASE_ENV; pg8::StaticOrder SO; pg8::Gemm g{P_XB, P_W(WS_WIN), M, INW, D}; SO.init(M, INW, G, blockIdx.x); stage_row_ss(lds, P_SS + (size_t)(3 * l + 1) * 8 * M, SO); EpiProj E{P_PROJ, P_KMP, P_ROPE, (const LAS float*)(lds + LDS_RS), (bf16_t*)(ws + WS_GRL)}; pg8::gemm_phase(lds, g, SO, E); }
        GSYNC;
        { PHASE_ENV;
        for (int pair = blockIdx.x; pair < 256; pair += G) {
            const int bh = pair >> 4, q16 = pair & 15;
            moba_item(p, lds, bh >> 3, bh & 7, q16, 0);
            moba_item(p, lds, bh >> 3, bh & 7, 15 - q16, 1);
        }
        for (int it = blockIdx.x; it < 512; it += G) ret_kv_item(p, lds, it >> 8, (it >> 5) & 7, it & 31);
        }
        GSYNC;
        { PHASE_IDS; PHASE_ENV;
        for (int idx = blockIdx.x * 512 + tid; idx < 16 * 32768; idx += G * 512) {
            const int bh = idx >> 15, ed = idx & 32767, h = bh & 7;
            const float decay = __builtin_amdgcn_exp2f(128.0f * ret_log2g(h));
            const float* kv = P_KV + (size_t)bh * 32 * 32768 + ed;
            const int e_ = ed >> 7, d_ = ed & 127;
            const int foff = ((((e_ >> 7) * 4 + ((e_ >> 5) & 3)) * 8 + (d_ >> 4)) * 64 + ((d_ >> 3) & 1) * 32 + (e_ & 31)) * 8 + (d_ & 7);
            bf16_t* pt = P_PREVT + (size_t)bh * 32 * 32768 + foff;
            float kvv[32];
#pragma unroll
            for (int n = 0; n < 32; ++n) kvv[n] = kv[(size_t)n * 32768];
            float st = 0.f;
#pragma unroll
            for (int n = 0; n < 32; ++n) {
                pt[(size_t)n * 32768] = (bf16_t)(pk2(st, 0.f) & 0xffffu);
                st = decay * st + kvv[n];
            }
        } }
        GSYNC;
        { PHASE_ENV;
        for (int it = blockIdx.x; it < 512; it += G) ret_out_item(p, lds, it >> 8, (it >> 5) & 7, it & 31);
        }
        GSYNC;
        { PHASE_ENV; pg8::StaticOrder SO; pg8::Gemm g{P_YR, P_W(WS_WB), M, D, 2048}; SO.init(M, D, G, blockIdx.x); EpiBranchB E{P_T1, P_PROJ}; pg8::gemm_phase(lds, g, SO, E); }
        { PHASE_ENV; pg8::StaticOrder SO; pg8::Gemm g{P_Y, P_W(WS_WA), M, D, 1024}; SO.init(M, D, G, blockIdx.x); EpiBranchA E{P_T1, P_PROJ, P_MG}; pg8::gemm_phase(lds, g, SO, E); }
        GSYNC;
        { PHASE_ENV; pg8::StaticOrder SO; pg8::Gemm g{P_MG, P_W(WS_WO), M, D, D}; SO.init(M, D, G, blockIdx.x); EpiResidual E{P_X, P_X, P_XB, P_SS + (size_t)(3 * l + 2) * 8 * M, (LAS float*)(lds + LDS_RS), 1.0f}; pg8::gemm_phase(lds, g, SO, E); }
        GSYNC;
        { PHASE_ENV; pg8::StaticOrder SO; pg8::Gemm g{P_XB, P_W(WS_WGU2), M, 2 * DFF, D}; SO.init(M, 2 * DFF, G, blockIdx.x); stage_row_ss(lds, P_SS + (size_t)(3 * l + 2) * 8 * M, SO); EpiSwiGLU E{P_HID, (const LAS float*)(lds + LDS_RS)}; pg8::gemm_phase(lds, g, SO, E); }
        GSYNC;
        { PHASE_ENV; pg8::StaticOrder SO; pg8::Gemm g{P_HID, P_W(WS_WD2), M, D, DFF}; SO.init(M, D, G, blockIdx.x); EpiResidual E{P_X, P_X, P_XB, P_SS + (size_t)(3 * l + 3) * 8 * M, (LAS float*)(lds + LDS_RS), 0.5f}; pg8::gemm_phase(lds, g, SO, E); }
        GSYNC;
    }
    { PHASE_IDS; PHASE_ENV;
    for (int m = gw; m < M; m += ngw) rms_row<true>(P_X + (size_t)m * D, p.in[14], p.out + (size_t)m * D, lane); }
}

extern "C" void kernel_launch(void* const* d_in, const int* in_sizes, int n_in, void* d_out, int out_size, void* d_ws, size_t ws_size, hipStream_t stream) {
    static int grid = 0;
    if (grid == 0) {
        if (n_in != 15 || ws_size < WS_END) { fprintf(stderr, "kernel_launch: n_in %d ws %zu need %zu\n", n_in, ws_size, (size_t)WS_END); grid = -1; return; }
        int dev = 0, cus = 0, per_cu = 0;
        hipGetDevice(&dev);
        hipDeviceGetAttribute(&cus, hipDeviceAttributeMultiprocessorCount, dev);
        hipFuncSetAttribute((const void*)mega_fwd, hipFuncAttributeMaxDynamicSharedMemorySize, LDS_BYTES);
        hipOccupancyMaxActiveBlocksPerMultiprocessor(&per_cu, (const void*)mega_fwd, 512, LDS_BYTES);
        if (per_cu < 1) { fprintf(stderr, "kernel_launch: occupancy query says %d blocks per CU\n", per_cu); per_cu = 1; }
        (void)hipGetLastError();
        grid = cus * per_cu;
        if (grid > 256) grid = 256;
    }
    if (grid < 0) return;
    if (hipMemsetAsync((char*)d_ws + WS_CTL, 0, CTL_BYTES, stream) != hipSuccess) { fprintf(stderr, "memset failed\n"); return; }
    Params p{};
    for (int i = 0; i < 15; ++i) p.in[i] = (const float*)d_in[i];
    p.out = (float*)d_out; p.ws = (unsigned char*)d_ws;
    void* args[] = {&p};
    hipError_t e = hipLaunchCooperativeKernel((const void*)mega_fwd, dim3(grid), dim3(512), args, LDS_BYTES, stream);
    if (e != hipSuccess) fprintf(stderr, "cooperative launch failed: %s (grid %d)\n", hipGetErrorString(e), grid);
}
```

```cpp
#include <hip/hip_runtime.h>
#include <hip/hip_cooperative_groups.h>
#include <cstdio>
#include <cstdint>
namespace cg = cooperative_groups;

#ifndef PROBE_ID
#define PROBE_ID 0
#endif
#define LAS __attribute__((address_space(3)))
typedef unsigned short bf16_t;
typedef short bf16x8 __attribute__((ext_vector_type(8)));
typedef short s16x4 __attribute__((ext_vector_type(4)));
typedef float f32x4 __attribute__((ext_vector_type(4)));
typedef float f32x2 __attribute__((ext_vector_type(2)));
typedef float f32x16 __attribute__((ext_vector_type(16)));
typedef unsigned u32x4 __attribute__((ext_vector_type(4)));
typedef unsigned u32x2 __attribute__((ext_vector_type(2)));
typedef __bf16 bf16x2_t __attribute__((ext_vector_type(2)));

constexpr int D = 2048, NB = 2, S = 4096, M = NB * S, DFF = 5632, INW = 13312, DEPTH = 2;
constexpr int C_QA = 0, C_KA = 1024, C_VA = 2048, C_QR = 3072, C_KR = 4096, C_VR = 5120, C_GR = 7168, C_GA = 9216, C_GB = 11264;
constexpr int YW = 3072;
constexpr int LDS_BYTES = 155648;
constexpr int LDS_RS = 131072;

constexpr size_t al256(size_t x) { return (x + 255) & ~(size_t)255; }
constexpr size_t WS_WGU1 = 0;
constexpr size_t WS_WD1 = WS_WGU1 + al256((size_t)2 * DFF * D * 2);
constexpr size_t WS_WIN = WS_WD1 + al256((size_t)D * DFF * 2);
constexpr size_t WS_WA = WS_WIN + al256((size_t)INW * D * 2);
constexpr size_t WS_WB = WS_WA + al256((size_t)D * 1024 * 2);
constexpr size_t WS_WO = WS_WB + al256((size_t)D * 2048 * 2);
constexpr size_t WS_WGU2 = WS_WO + al256((size_t)D * D * 2);
constexpr size_t WS_WD2 = WS_WGU2 + al256((size_t)2 * DFF * D * 2);
constexpr size_t WS_X = WS_WD2 + al256((size_t)D * DFF * 2);
constexpr size_t WS_XN = WS_X + al256((size_t)M * D * 4);
constexpr size_t WS_HID = WS_XN + al256((size_t)M * D * 2);
constexpr size_t WS_PROJ = WS_HID + al256((size_t)M * DFF * 2);
constexpr size_t WS_Y = WS_PROJ + al256((size_t)M * INW * 2);
constexpr size_t WS_YR = WS_Y + al256((size_t)M * 1024 * 2);
constexpr size_t WS_KMP = WS_YR + al256((size_t)M * 2048 * 2);
constexpr size_t WS_ROPE = WS_KMP + al256((size_t)2 * 32 * 1024 * 4);
constexpr size_t WS_XB = WS_ROPE + al256((size_t)4 * 4096 * 64 * 4);
constexpr size_t WS_SS = WS_XB + al256((size_t)M * D * 2);
constexpr size_t WS_GRL = WS_SS + al256((size_t)7 * 32 * M * 4);
constexpr size_t WS_CTL = WS_GRL + al256((size_t)M * 2048 * 2);
constexpr size_t CTL_BYTES = 16384;
constexpr size_t WS_END = WS_CTL + CTL_BYTES;

struct Params {
    const float* in[15];
    float* out;
    unsigned char* ws;
};

__device__ __forceinline__ unsigned pk2(float lo, float hi) { f32x2 f = {lo, hi}; bf16x2_t b = __builtin_convertvector(f, bf16x2_t); return __builtin_bit_cast(unsigned, b); }
__device__ __forceinline__ float bflo(unsigned u) { return __uint_as_float(u << 16); }
__device__ __forceinline__ float bfhi(unsigned u) { return __uint_as_float(u & 0xffff0000u); }
__device__ __forceinline__ float fast_rcp(float x) { return __builtin_amdgcn_rcpf(x); }
__device__ __forceinline__ float sigmoidf_(float x) { return fast_rcp(1.0f + __expf(-x)); }
__device__ __forceinline__ float siluf_(float x) { return x * sigmoidf_(x); }
__device__ __forceinline__ float wave_sum(float v) {
#pragma unroll
    for (int o = 1; o < 64; o <<= 1) v += __shfl_xor(v, o);
    return v;
}
__device__ __forceinline__ int otid() { int x = threadIdx.x; asm volatile("" : "+v"(x)); return x; }
__device__ __forceinline__ unsigned char* opq_ptr(unsigned char* q) { int z = 0; asm volatile("" : "+s"(z)); return q + z; }
__device__ __forceinline__ int opq_int(int v) { asm volatile("" : "+s"(v)); return v; }
#define MFMA32(a, b, c) __builtin_amdgcn_mfma_f32_32x32x16_bf16((a), (b), (c), 0, 0, 0)
__device__ __forceinline__ int crow(int reg, int h) { return (reg & 3) + 8 * (reg >> 2) + 4 * h; }
__device__ __forceinline__ s16x4 tr_read(LAS unsigned char* p) { return __builtin_amdgcn_ds_read_tr16_b64_v4i16((LAS s16x4*)p); }
__device__ __forceinline__ bf16x8 tr_read2(LAS unsigned char* p, int hi_off) {
    s16x4 lo = tr_read(p), hi = tr_read(p + hi_off);
    return __builtin_shufflevector(lo, hi, 0, 1, 2, 3, 4, 5, 6, 7);
}
template <int s2> __device__ __forceinline__ bf16x8 pack_step(const f32x16& x) {
    u32x4 p; p.x = pk2(x[8 * s2 + 0], x[8 * s2 + 1]); p.y = pk2(x[8 * s2 + 2], x[8 * s2 + 3]); p.z = pk2(x[8 * s2 + 4], x[8 * s2 + 5]); p.w = pk2(x[8 * s2 + 6], x[8 * s2 + 7]);
    return __builtin_bit_cast(bf16x8, p);
}


#define XB_TMO      128
#define XB_XCNT(j)  (256  + 64 * (j))
#define XB_XSUB(j)  (1280 + 64 * (j))
#define XB_XGEN(j)  (2304 + 64 * (j))
#define XB_TOP      3328
#define XB_TOPGEN   3392
#define XCD_BAR_WORDS 3456
#define XB_SPIN_CAP (1u << 18)
__device__ __forceinline__ unsigned xb_ld(unsigned* p)              { return __hip_atomic_load(p, __ATOMIC_RELAXED, __HIP_MEMORY_SCOPE_AGENT); }
__device__ __forceinline__ unsigned xb_add(unsigned* p, unsigned v) { return __hip_atomic_fetch_add(p, v, __ATOMIC_RELAXED, __HIP_MEMORY_SCOPE_AGENT); }
__device__ __forceinline__ unsigned xb_xcc_id() { return (unsigned)__builtin_amdgcn_s_getreg((3 << 11) | 20) & 0xFu; }
#define XB_SPIN(cond, bar) do { unsigned _sp = 0; while (cond) { __builtin_amdgcn_s_sleep(1); \
    if ((++_sp & 255u) == 0u) { if (xb_ld(&(bar)[XB_TMO])) break; if (_sp > XB_SPIN_CAP) { atomicAdd(&(bar)[XB_TMO], 1u); break; } } } } while (0)
__device__ __forceinline__ void xcd_barrier_post(unsigned* bar) {
    const unsigned x = xb_xcc_id();
    if (threadIdx.x == 0) (void)xb_add(&bar[XB_XCNT(x)], 1u);
}
__device__ __forceinline__ void xcd_barrier_complete(unsigned* bar, unsigned x, unsigned& nloc, unsigned& nx) {
    const unsigned G = gridDim.x * gridDim.y * gridDim.z;
    unsigned sum, cnt, mine, sp = 0u;
    for (;;) {
        sum = 0u; cnt = 0u; mine = 0u;
#pragma unroll
        for (unsigned j = 0; j < 16; ++j) { const unsigned c = xb_ld(&bar[XB_XCNT(j)]); sum += c; cnt += (c > 0u) ? 1u : 0u; mine = (j == x) ? c : mine; }
        if (sum == G) break;
        __builtin_amdgcn_s_sleep(1);
        if ((++sp & 255u) == 0u) { if (xb_ld(&bar[XB_TMO])) break; if (sp > XB_SPIN_CAP) { atomicAdd(&bar[XB_TMO], 1u); break; } }
    }
    nloc = mine > 0u ? mine : 1u; nx = cnt > 0u ? cnt : 1u;
}
__device__ __forceinline__ void xcd_barrier(unsigned char* ws_base, volatile LAS unsigned* st) {
    asm volatile("s_waitcnt vmcnt(0)" ::: "memory");
    __syncthreads();
    if (threadIdx.x == 0) {
        unsigned long long a = (unsigned long long)(ws_base + WS_CTL);
        asm volatile("" : "+s"(a));
        unsigned* bar = (unsigned*)a;
        const unsigned x = xb_xcc_id();
        __builtin_amdgcn_s_waitcnt(0);
        unsigned nloc = st[0], nx = st[1];
        if (nloc == 0u) { xcd_barrier_complete(bar, x, nloc, nx); st[0] = nloc; st[1] = nx; }
        const unsigned old = xb_add(&bar[XB_XSUB(x)], 1u);
        const unsigned gen = old / nloc;
        if (old + 1u == (gen + 1u) * nloc) {
            __builtin_amdgcn_fence(__ATOMIC_RELEASE, "agent");
            asm volatile("s_waitcnt vmcnt(0)" ::: "memory");
            const unsigned og = xb_add(&bar[XB_TOP], 1u);
            const unsigned tg = og / nx;
            if (og + 1u == (tg + 1u) * nx) xb_add(&bar[XB_TOPGEN], 1u);
            else XB_SPIN(xb_ld(&bar[XB_TOPGEN]) == tg, bar);
            __builtin_amdgcn_fence(__ATOMIC_ACQUIRE, "agent");
            xb_add(&bar[XB_XGEN(x)], 1u);
            asm volatile("s_waitcnt vmcnt(0)" ::: "memory");
        } else {
            XB_SPIN(xb_ld(&bar[XB_XGEN(x)]) == gen, bar);
            __builtin_amdgcn_fence(__ATOMIC_ACQUIRE, "agent");
            asm volatile("s_waitcnt vmcnt(0)" ::: "memory");
        }
    }
    __syncthreads();
}

namespace pg8 {
constexpr int BM = 256, BK = 64, HALF = 128, HTB = HALF * BK * 2, STAGE_BYTES = 8 * HTB, NXCD = 8, WGM = 8;
__host__ __device__ __forceinline__ int lds_byte(int r, int c) { const int st = (r >> 4) * 2 + (c >> 5), rr = r & 15, cc = c & 31, ob = rr * 64 + cc * 2; return st * 1024 + (ob ^ (((ob >> 9) & 1) << 5)); }
__host__ __device__ __forceinline__ void stage_rc(int b, int& R, int& C) { const int st = b / 1024, sb = b % 1024, swz = sb ^ (((sb >> 9) & 1) << 5); R = (st >> 1) * 16 + swz / 64; C = (st & 1) * 32 + (swz % 64) / 2; }
__host__ __device__ __forceinline__ int perm32(int rho) { const int n = rho >> 4, i = rho & 15; return 8 * (i >> 2) + 4 * n + (i & 3); }
struct Unit { int pm, pn, ord; };
struct Gemm { const bf16_t* A; const bf16_t* Bt; int M, N, K; };
struct StaticOrder {
    int nM, nN, nwg, G, c;
    __host__ __device__ void init(int M_, int N_, int G_, int c_) { nM = M_ / BM; nN = N_ / BM; nwg = nM * nN; G = G_; c = c_; }
    __host__ __device__ bool next(int i, Unit& u) const {
        const long L = (long)i * G + c; if (L >= nwg) return false;
        int wgid = (int)L; { const int q = nwg / NXCD, r = nwg % NXCD, xcd = wgid % NXCD, off = wgid / NXCD; wgid = (xcd < r ? xcd * (q + 1) : r * (q + 1) + (xcd - r) * q) + off; }
        const int nig = WGM * nN, gid = wgid / nig, fm = gid * WGM, gsz = (nM - fm) < WGM ? (nM - fm) : WGM;
        u.pm = fm + ((wgid % nig) % gsz); u.pn = (wgid % nig) / gsz; u.ord = i; return true;
    }
};
template <class Epi>
__device__ __forceinline__ void gemm_phase(LAS unsigned char* lds, const Gemm g, const StaticOrder& S, const Epi& E) {
    const int tid = otid(), wid = __builtin_amdgcn_readfirstlane(tid >> 6), lane = tid & 63, wr = wid >> 2, wc = wid & 3, fr = lane & 15, fq = lane >> 4;
    const int K = g.K, nt = K / BK;
    unsigned voffA[2], voffB[2];
#pragma unroll
    for (int i = 0; i < 2; ++i) { voffA[i] = (unsigned)(tid * 16 + i * 8192); voffB[i] = voffA[i]; }
    const size_t kstep = (size_t)HTB;
    const size_t hstep = (size_t)(K / BK) * HTB;
    const size_t tstep = 2 * hstep;
    const unsigned ldsw = (unsigned)wid * 1024u;
    const int aoff = lds_byte(wr * 64 + fr, fq * 8), boff = lds_byte(wc * 32 + fr, fq * 8);
#define PG8_SA(b, h) (((b) * 2 + (h)) * HTB)
#define PG8_SB(b, h) ((4 + (b) * 2 + (h)) * HTB)
#define PG8_STAGE(bufoff, gbase, voff) do { _Pragma("unroll") for (int _i = 0; _i < 2; ++_i) \
        __builtin_amdgcn_global_load_lds((const unsigned*)((const char*)(gbase) + (voff)[_i]), (LAS unsigned*)(lds + (bufoff) + ldsw + _i * 8192), 16, 0, 0); } while (0)
#define PG8_LDA(dst, b, h) do { _Pragma("unroll") for (int m = 0; m < 4; ++m) _Pragma("unroll") for (int k = 0; k < 2; ++k) dst[m][k] = *(const LAS bf16x8*)(lds + PG8_SA(b, h) + aoff + m * 2048 + k * 1024); } while (0)
#define PG8_LDB(dst, b, h) do { _Pragma("unroll") for (int n = 0; n < 2; ++n) _Pragma("unroll") for (int k = 0; k < 2; ++k) dst[n][k] = *(const LAS bf16x8*)(lds + PG8_SB(b, h) + boff + n * 2048 + k * 1024); } while (0)
#define PG8_MMA(ai, bj, At, Bt) do { __builtin_amdgcn_s_setprio(1); _Pragma("unroll") for (int m = 0; m < 4; ++m) _Pragma("unroll") for (int n = 0; n < 2; ++n) _Pragma("unroll") for (int k = 0; k < 2; ++k) \
        acc[ai][bj][m][n] = __builtin_amdgcn_mfma_f32_16x16x32_bf16(Bt[n][k], At[m][k], acc[ai][bj][m][n], 0, 0, 0); __builtin_amdgcn_s_setprio(0); } while (0)
#define PG8_WAIT_V(n) asm volatile("s_waitcnt vmcnt(" #n ")" ::: "memory")
#define PG8_WAIT_L(n) asm volatile("s_waitcnt lgkmcnt(" #n ")" ::: "memory")
#define PG8_BAR __builtin_amdgcn_s_barrier()
#define PG8_SCHED __builtin_amdgcn_sched_barrier(0)
    Unit cur, nxt; int ui = 0;
    if (!S.next(0, cur)) return;
    f32x4 acc[2][2][4][2];
#pragma unroll
    for (int a = 0; a < 2; ++a)
#pragma unroll
        for (int b = 0; b < 2; ++b)
#pragma unroll
            for (int m = 0; m < 4; ++m)
#pragma unroll
                for (int n = 0; n < 2; ++n) acc[a][b][m][n] = (f32x4){0.f, 0.f, 0.f, 0.f};
    bf16x8 At[4][2], B0[2][2], B1[2][2];
    const char* cA = (const char*)g.A + (size_t)cur.pm * tstep; const char* cB = (const char*)g.Bt + (size_t)cur.pn * tstep;
    PG8_STAGE(PG8_SB(0, 0), cB, voffB); PG8_STAGE(PG8_SB(0, 1), cB + hstep, voffB); PG8_STAGE(PG8_SA(0, 0), cA, voffA); PG8_STAGE(PG8_SA(0, 1), cA + hstep, voffA);
    if (wr == 1) PG8_BAR;
    PG8_WAIT_V(2); PG8_BAR;
    PG8_STAGE(PG8_SB(1, 0), cB + kstep, voffB); PG8_STAGE(PG8_SA(1, 0), cA + kstep, voffA); PG8_STAGE(PG8_SB(1, 1), cB + hstep + kstep, voffB);
    PG8_WAIT_V(6); PG8_BAR;
    for (;;) {
        const bool has_next = S.next(ui + 1, nxt);
        const char* nA = has_next ? (const char*)g.A + (size_t)nxt.pm * tstep : cA; const char* nB = has_next ? (const char*)g.Bt + (size_t)nxt.pn * tstep : cB;
        for (int t = 0; t < nt; t += 2) {
            const bool last = (t == nt - 2);
            const char* a1 = cA + (size_t)(t + 1) * kstep;
            const char* a2 = last ? nA : cA + (size_t)(t + 2) * kstep; const char* b2 = last ? nB : cB + (size_t)(t + 2) * kstep;
            const char* a3 = a2 + kstep; const char* b3 = b2 + kstep;
            PG8_LDB(B0, 0, 0); PG8_LDB(B1, 0, 1); PG8_SCHED; PG8_LDA(At, 0, 0); PG8_STAGE(PG8_SA(1, 1), a1 + hstep, voffA);
            PG8_WAIT_V(8); PG8_WAIT_L(0); PG8_BAR; PG8_MMA(0, 0, At, B0); PG8_MMA(0, 1, At, B1); PG8_BAR; PG8_SCHED;
            PG8_LDA(At, 0, 1); PG8_STAGE(PG8_SB(0, 0), b2, voffB); PG8_STAGE(PG8_SB(0, 1), b2 + hstep, voffB); PG8_STAGE(PG8_SA(0, 0), a2, voffA);
            PG8_WAIT_V(8); PG8_WAIT_L(0); PG8_BAR; PG8_MMA(1, 0, At, B0); PG8_MMA(1, 1, At, B1); PG8_BAR; PG8_SCHED;
            PG8_LDB(B0, 1, 0); PG8_LDB(B1, 1, 1); PG8_SCHED; PG8_LDA(At, 1, 0); PG8_STAGE(PG8_SA(0, 1), a2 + hstep, voffA);
            PG8_WAIT_V(8); PG8_WAIT_L(0); PG8_BAR; PG8_MMA(0, 0, At, B0); PG8_MMA(0, 1, At, B1); PG8_BAR; PG8_SCHED;
            PG8_LDA(At, 1, 1); PG8_STAGE(PG8_SB(1, 0), b3, voffB); PG8_STAGE(PG8_SB(1, 1), b3 + hstep, voffB); PG8_STAGE(PG8_SA(1, 0), a3, voffA);
            PG8_WAIT_V(8); PG8_WAIT_L(0); PG8_BAR; PG8_MMA(1, 0, At, B0); PG8_MMA(1, 1, At, B1); PG8_BAR; PG8_SCHED;
        }
        if (wr == 0) PG8_BAR;
        E(acc, cur, wr, wc, fr, fq);
        if (!has_next) break;
#pragma unroll
        for (int a = 0; a < 2; ++a)
#pragma unroll
            for (int b = 0; b < 2; ++b)
#pragma unroll
                for (int m = 0; m < 4; ++m)
#pragma unroll
                    for (int n = 0; n < 2; ++n) acc[a][b][m][n] = (f32x4){0.f, 0.f, 0.f, 0.f};
        cur = nxt; cA = nA; cB = nB; ++ui;
        if (wr == 1) PG8_BAR;
    }
    PG8_WAIT_V(0);
    PG8_BAR;
#undef PG8_SA
#undef PG8_SB
#undef PG8_STAGE
#undef PG8_LDA
#undef PG8_LDB
#undef PG8_MMA
#undef PG8_WAIT_V
#undef PG8_WAIT_L
#undef PG8_BAR
#undef PG8_SCHED
}
}
using pg8::Unit;
__device__ __forceinline__ size_t tiled_off(int row, int col, int nkt) {
    return ((size_t)(row >> 7) * nkt + (col >> 6)) * 16384 + (size_t)pg8::lds_byte(row & 127, col & 63);
}
__device__ __forceinline__ int invperm32(int w) { return 16 * ((w >> 2) & 1) + 4 * (w >> 3) + (w & 3); }
typedef f32x4 AccT[2][2][4][2];
__device__ __forceinline__ float row_rstd(const LAS float* RS, int ord, int lrow) {
    const float ssum = RS[ord * 256 + lrow] + RS[2048 + ord * 256 + lrow];
    return 1.0f / sqrtf(ssum * (1.0f / D) + 1e-6f);
}
__device__ __forceinline__ void stage_row_ss(LAS unsigned char* lds, const float* SS, const pg8::StaticOrder& S) {
    LAS float* RS = (LAS float*)(lds + LDS_RS);
    const int tid = otid(), wave = __builtin_amdgcn_readfirstlane(tid >> 6), lane = tid & 63;
    pg8::Unit u;
    if (S.next(wave, u)) {
        const float* sp = SS + u.pm * 256 + lane;
        float a[4];
#pragma unroll
        for (int j = 0; j < 4; ++j) a[j] = 0.f;
#pragma unroll
        for (int t = 0; t < 8; ++t)
#pragma unroll
            for (int j = 0; j < 4; ++j) a[j] += sp[(size_t)t * M + 64 * j];
#pragma unroll
        for (int j = 0; j < 4; ++j) { RS[wave * 256 + lane + 64 * j] = a[j]; RS[2048 + wave * 256 + lane + 64 * j] = 0.f; }
    }
    __syncthreads();
}
struct EpiSwiGLU {
    static constexpr bool PERM = true;
    bf16_t* H; const LAS float* RS;
    __device__ __forceinline__ void operator()(const AccT& acc, const Unit& u, int wr, int wc, int fr, int fq) const {
        const int row0 = u.pm * 256 + wr * 64 + fr, col0 = u.pn * 128 + wc * 32 + 8 * fq;
#pragma unroll
        for (int ai = 0; ai < 2; ++ai)
#pragma unroll
            for (int m = 0; m < 4; ++m) {
                const int row = row0 + ai * 128 + m * 16;
                const float rstd = row_rstd(RS, u.ord, wr * 64 + fr + ai * 128 + m * 16);
                bf16_t* rowp = H + (size_t)row * DFF + col0;
                float v[8];
#pragma unroll
                for (int n = 0; n < 2; ++n)
#pragma unroll
                    for (int e = 0; e < 4; ++e) v[4 * n + e] = siluf_(acc[ai][0][m][n][e] * rstd) * (acc[ai][1][m][n][e] * rstd);
                u32x4 w; w.x = pk2(v[0], v[1]); w.y = pk2(v[2], v[3]); w.z = pk2(v[4], v[5]); w.w = pk2(v[6], v[7]);
                *(u32x4*)((char*)H + tiled_off(row, col0, DFF / 64)) = w;
            }
    }
};
struct EpiResidual {
    static constexpr bool PERM = false;
    const float* src; float* dst; bf16_t* XB; float* SS; LAS float* RSW; float alpha;
    __device__ __forceinline__ void operator()(const AccT& acc, const Unit& u, int wr, int wc, int fr, int fq) const {
        const int row0 = u.pm * 256 + wr * 64 + fr, col0 = u.pn * 256 + wc * 32 + 4 * fq;
#pragma unroll
        for (int ai = 0; ai < 2; ++ai) {
            f32x4 xv[4][2][2];
#pragma unroll
            for (int m = 0; m < 4; ++m)
#pragma unroll
                for (int bj = 0; bj < 2; ++bj)
#pragma unroll
                    for (int n = 0; n < 2; ++n) xv[m][bj][n] = *(const f32x4*)(src + (size_t)(row0 + ai * 128 + m * 16) * D + col0 + bj * 128 + n * 16);
            __builtin_amdgcn_sched_barrier(0);
#pragma unroll
            for (int m = 0; m < 4; ++m) {
                const int row = row0 + ai * 128 + m * 16;
                const size_t ro = (size_t)row * D + col0;
                float ssq = 0.f;
#pragma unroll
                for (int bj = 0; bj < 2; ++bj)
#pragma unroll
                    for (int n = 0; n < 2; ++n) {
                        const f32x4 y = xv[m][bj][n] + alpha * acc[ai][bj][m][n];
                        *(f32x4*)(dst + ro + bj * 128 + n * 16) = y;
                        u32x2 w; w.x = pk2(y[0], y[1]); w.y = pk2(y[2], y[3]);
                        *(u32x2*)((char*)XB + tiled_off(row, col0 + bj * 128 + n * 16, D / 64)) = w;
                        ssq += (y[0] * y[0] + y[1] * y[1]) + (y[2] * y[2] + y[3] * y[3]);
                    }
                ssq += __shfl_xor(ssq, 16); ssq += __shfl_xor(ssq, 32);
                if (fq == 0) RSW[wc * 256 + (row & 255)] = ssq;
            }
            __builtin_amdgcn_sched_barrier(0);
        }
        __syncthreads();
        { const int t = wr * 256 + wc * 64 + fq * 16 + fr;
          if (t < 256) SS[(size_t)u.pn * M + u.pm * 256 + t] = (RSW[t] + RSW[256 + t]) + (RSW[512 + t] + RSW[768 + t]); }
        __syncthreads();
    }
};
struct EpiProj {
    static constexpr bool PERM = true;
    bf16_t* P; float* KMP; const float* rope; const LAS float* RS; bf16_t* GRL;
    __device__ __forceinline__ void operator()(const AccT& acc, const Unit& u, int wr, int wc, int fr, int fq) const {
        const int row0 = u.pm * 256 + wr * 64 + fr, col0 = u.pn * 256 + wc * 32 + 8 * fq;
        const int pn = u.pn;
        const bool rot = (pn < 8) || (pn >= 12 && pn < 20);
        const bool isgr = (pn >= 28 && pn < 36);
        if (!rot) {
#pragma unroll
            for (int ai = 0; ai < 2; ++ai)
#pragma unroll
                for (int m = 0; m < 4; ++m) {
                    const int row = row0 + ai * 128 + m * 16;
                    const float rstd = row_rstd(RS, u.ord, wr * 64 + fr + ai * 128 + m * 16);
                    bf16_t* rowp = P + (size_t)row * INW + col0;
#pragma unroll
                    for (int bj = 0; bj < 2; ++bj) {
                        const f32x4 v0 = acc[ai][bj][m][0] * rstd, v1 = acc[ai][bj][m][1] * rstd;
                        u32x4 w; w.x = pk2(v0[0], v0[1]); w.y = pk2(v0[2], v0[3]); w.z = pk2(v1[0], v1[1]); w.w = pk2(v1[2], v1[3]);
                        if (isgr) {
                            const int sp = row & (S - 1), tl = sp & 127;
                            bf16_t* gb = GRL + ((size_t)(((row >> 12) * 8 + (pn - 28)) * 32 + (sp >> 7))) * 32768
                                       + (size_t)((((((bj * 4 + wc) * 4 + fq) * 4 + (tl >> 5)) * 2) * 32 + (tl & 31)) * 4);
                            u32x2 lo2; lo2.x = w.x; lo2.y = w.y; u32x2 hi2; hi2.x = w.z; hi2.y = w.w;
                            *(u32x2*)gb = lo2; *(u32x2*)(gb + 32 * 4) = hi2;
                        } else *(u32x4*)(rowp + bj * 128) = w;
                    }
                }
            return;
        }
        const bool kindr = pn >= 12;
        const float* ctab = rope + (kindr ? 2 : 0) * (4096 * 64);
        const float* stab = ctab + 4096 * 64;
        const float sc = (pn >= 16 && pn < 20) ? 0.08838834764831845f : 1.0f;
        const bool kmean = (pn >= 4 && pn < 8);
        f32x4 cs[2][2];
#pragma unroll
        for (int bj = 0; bj < 2; ++bj)
#pragma unroll
            for (int n = 0; n < 2; ++n) cs[bj][n] = (f32x4){0.f, 0.f, 0.f, 0.f};
        f32x4 cv[2][4], sv[2][4];
#pragma unroll
        for (int ai = 0; ai < 2; ++ai)
#pragma unroll
            for (int m = 0; m < 4; ++m) {
                const int pos = (row0 + ai * 128 + m * 16) & (S - 1);
                cv[ai][m] = *(const f32x4*)(ctab + pos * 64 + wc * 16 + fq * 4);
                sv[ai][m] = *(const f32x4*)(stab + pos * 64 + wc * 16 + fq * 4);
            }
        __builtin_amdgcn_sched_barrier(0);
#pragma unroll
        for (int ai = 0; ai < 2; ++ai)
#pragma unroll
            for (int m = 0; m < 4; ++m) {
                const int row = row0 + ai * 128 + m * 16;
                const float rs = sc * row_rstd(RS, u.ord, wr * 64 + fr + ai * 128 + m * 16);
                const f32x4 c4 = cv[ai][m] * rs;
                const f32x4 s4 = sv[ai][m] * rs;
                bf16_t* rowp = P + (size_t)row * INW + col0;
#pragma unroll
                for (int bj = 0; bj < 2; ++bj) {
                    const f32x4 x1 = acc[ai][bj][m][0], x2 = acc[ai][bj][m][1];
                    const f32x4 o1 = x1 * c4 - x2 * s4, o2 = x1 * s4 + x2 * c4;
                    cs[bj][0] += o1; cs[bj][1] += o2;
                    u32x4 w; w.x = pk2(o1[0], o1[1]); w.y = pk2(o1[2], o1[3]); w.z = pk2(o2[0], o2[1]); w.w = pk2(o2[2], o2[3]);
                    *(u32x4*)(rowp + bj * 128) = w;
                }
            }
        if (kmean) {
#pragma unroll
            for (int bj = 0; bj < 2; ++bj)
#pragma unroll
                for (int n = 0; n < 2; ++n)
#pragma unroll
                    for (int e = 0; e < 4; ++e) {
                        float v = cs[bj][n][e];
                        v += __shfl_xor(v, 1); v += __shfl_xor(v, 2); v += __shfl_xor(v, 4); v += __shfl_xor(v, 8);
                        cs[bj][n][e] = v;
                    }
            if (fr == 0) {
                float* kp = KMP + ((size_t)wr * 32 + u.pm) * 1024 + (pn - 4) * 256 + wc * 32 + 8 * fq;
#pragma unroll
                for (int bj = 0; bj < 2; ++bj) { *(f32x4*)(kp + bj * 128) = cs[bj][0]; *(f32x4*)(kp + bj * 128 + 4) = cs[bj][1]; }
            }
        }
    }
};
struct EpiBranchB {
    static constexpr bool PERM = true;
    float* T1; const bf16_t* P;
    __device__ __forceinline__ void operator()(const AccT& acc, const Unit& u, int wr, int wc, int fr, int fq) const {
        const int row0 = u.pm * 256 + wr * 64 + fr, col0 = u.pn * 256 + wc * 32 + 8 * fq;
        u32x4 gv[2][4][2];
#pragma unroll
        for (int ai = 0; ai < 2; ++ai)
#pragma unroll
            for (int m = 0; m < 4; ++m)
#pragma unroll
                for (int bj = 0; bj < 2; ++bj) gv[ai][m][bj] = *(const u32x4*)(P + (size_t)(row0 + ai * 128 + m * 16) * INW + C_GB + col0 + bj * 128);
        __builtin_amdgcn_sched_barrier(0);
#pragma unroll
        for (int ai = 0; ai < 2; ++ai)
#pragma unroll
            for (int m = 0; m < 4; ++m) {
                const size_t row = (size_t)(row0 + ai * 128 + m * 16);
#pragma unroll
                for (int bj = 0; bj < 2; ++bj) {
                    const u32x4 g = gv[ai][m][bj];
                    f32x4 o0, o1;
                    o0[0] = sigmoidf_(bflo(g.x)) * acc[ai][bj][m][0][0]; o0[1] = sigmoidf_(bfhi(g.x)) * acc[ai][bj][m][0][1];
                    o0[2] = sigmoidf_(bflo(g.y)) * acc[ai][bj][m][0][2]; o0[3] = sigmoidf_(bfhi(g.y)) * acc[ai][bj][m][0][3];
                    o1[0] = sigmoidf_(bflo(g.z)) * acc[ai][bj][m][1][0]; o1[1] = sigmoidf_(bfhi(g.z)) * acc[ai][bj][m][1][1];
                    o1[2] = sigmoidf_(bflo(g.w)) * acc[ai][bj][m][1][2]; o1[3] = sigmoidf_(bfhi(g.w)) * acc[ai][bj][m][1][3];
                    float* tp = T1 + row * D + col0 + bj * 128;
                    *(f32x4*)tp = o0; *(f32x4*)(tp + 4) = o1;
                }
            }
    }
};
struct EpiBranchA {
    static constexpr bool PERM = true;
    const float* T1; const bf16_t* P; bf16_t* MG;
    __device__ __forceinline__ void operator()(const AccT& acc, const Unit& u, int wr, int wc, int fr, int fq) const {
        const int row0 = u.pm * 256 + wr * 64 + fr, col0 = u.pn * 256 + wc * 32 + 8 * fq;
#pragma unroll
        for (int ai = 0; ai < 2; ++ai)
#pragma unroll
            for (int mp = 0; mp < 2; ++mp) {
                u32x4 gv[2][2]; f32x4 tv[2][2][2];
#pragma unroll
                for (int mi = 0; mi < 2; ++mi)
#pragma unroll
                    for (int bj = 0; bj < 2; ++bj) {
                        const size_t row = (size_t)(row0 + ai * 128 + (2 * mp + mi) * 16);
                        gv[mi][bj] = *(const u32x4*)(P + row * INW + C_GA + col0 + bj * 128);
                        const float* tp = T1 + row * D + col0 + bj * 128;
                        tv[mi][bj][0] = *(const f32x4*)tp; tv[mi][bj][1] = *(const f32x4*)(tp + 4);
                    }
                __builtin_amdgcn_sched_barrier(0);
#pragma unroll
                for (int mi = 0; mi < 2; ++mi)
#pragma unroll
                    for (int bj = 0; bj < 2; ++bj) {
                        const int m = 2 * mp + mi;
                        const size_t row = (size_t)(row0 + ai * 128 + m * 16);
                        const u32x4 g = gv[mi][bj];
                        const f32x4 t0 = tv[mi][bj][0], t1 = tv[mi][bj][1];
                        float o[8];
                        o[0] = t0[0] + sigmoidf_(bflo(g.x)) * acc[ai][bj][m][0][0]; o[1] = t0[1] + sigmoidf_(bfhi(g.x)) * acc[ai][bj][m][0][1];
                        o[2] = t0[2] + sigmoidf_(bflo(g.y)) * acc[ai][bj][m][0][2]; o[3] = t0[3] + sigmoidf_(bfhi(g.y)) * acc[ai][bj][m][0][3];
                        o[4] = t1[0] + sigmoidf_(bflo(g.z)) * acc[ai][bj][m][1][0]; o[5] = t1[1] + sigmoidf_(bfhi(g.z)) * acc[ai][bj][m][1][1];
                        o[6] = t1[2] + sigmoidf_(bflo(g.w)) * acc[ai][bj][m][1][2]; o[7] = t1[3] + sigmoidf_(bfhi(g.w)) * acc[ai][bj][m][1][3];
                        u32x4 w; w.x = pk2(o[0], o[1]); w.y = pk2(o[2], o[3]); w.z = pk2(o[4], o[5]); w.w = pk2(o[6], o[7]);
                        *(u32x4*)((char*)MG + tiled_off((int)row, col0 + bj * 128, D / 64)) = w;
                    }
                __builtin_amdgcn_sched_barrier(0);
            }
    }
};

template <int MAP> __device__ __forceinline__ int rowmap(int n) {
    if (MAP == 1) return (n >> 7) * 256 + (n & 127);
    if (MAP == 2) return (n >> 7) * 256 + 128 + (n & 127);
    if (MAP == 3) {
        const bool rot = (n < 2048) || (n >= 3072 && n < 5120);
        if (!rot) return n;
        const int c = n & 127, i = c & 63, half = c >> 6;
        return (n & ~127) + 32 * (i >> 4) + 8 * ((i >> 2) & 3) + 4 * half + (i & 3);
    }
    return n;
}
__device__ __forceinline__ void tr_load(const float* W, int N, int item, int lane, float (&wv)[32]) {
    const int nblk = N / 32, kb = item / nblk, nb = item % nblk, k0 = 64 * kb, n0 = 32 * nb;
#pragma unroll
    for (int i = 0; i < 32; ++i) { const int kk = 2 * i + (lane >> 5); wv[i] = __builtin_nontemporal_load(W + (size_t)(k0 + kk) * N + n0 + (lane & 31)); }
}
template <int MAP, bool HASG, bool PERMW>
__device__ __forceinline__ void tr_store(int K, int N, bf16_t* WT, LAS float* scr, int item, int lane, const float* gk) {
    const int nblk = N / 32, kb = item / nblk, nb = item % nblk, k0 = 64 * kb, n0 = 32 * nb;
    asm volatile("s_waitcnt lgkmcnt(0)" ::: "memory");
    const int c = lane & 7;
    f32x4 g0 = {1.f, 1.f, 1.f, 1.f}, g1 = {1.f, 1.f, 1.f, 1.f};
    if (HASG) { g0 = *(const f32x4*)(gk + k0 + 8 * c); g1 = *(const f32x4*)(gk + k0 + 8 * c + 4); }
#pragma unroll
    for (int j = 0; j < 4; ++j) { const int n = (lane >> 3) + 8 * j; const LAS float* s = scr + (8 * c) * 33 + n;
        u32x4 o; o.x = pk2(s[0 * 33] * g0[0], s[1 * 33] * g0[1]); o.y = pk2(s[2 * 33] * g0[2], s[3 * 33] * g0[3]); o.z = pk2(s[4 * 33] * g1[0], s[5 * 33] * g1[1]); o.w = pk2(s[6 * 33] * g1[2], s[7 * 33] * g1[3]);
        const int wr_ = rowmap<MAP>(n0 + n), slot_ = PERMW ? ((wr_ & ~31) + invperm32(wr_ & 31)) : wr_;
        *(u32x4*)((char*)WT + tiled_off(slot_, k0 + 8 * c, K / 64)) = o; }
    asm volatile("s_waitcnt lgkmcnt(0)" ::: "memory");
}
template <int MAP, bool HASG = false, bool PERMW = false>
__device__ __forceinline__ void transpose_mat(const float* W, int K, int N, bf16_t* WT, LAS float* scr, int gw, int ngw, int lane, const float* gk = nullptr) {
    const int nitems = (K / 64) * (N / 32);
    int it = gw;
    if (it >= nitems) return;
    float wv[32];
    tr_load(W, N, it, lane, wv);
    for (;;) {
        __builtin_amdgcn_sched_barrier(0);
#pragma unroll
        for (int i = 0; i < 32; ++i) { const int kk = 2 * i + (lane >> 5); scr[kk * 33 + (lane & 31)] = wv[i]; }
        __builtin_amdgcn_sched_barrier(0);
        const int nx = it + ngw;
        if (nx < nitems) tr_load(W, N, nx, lane, wv);
        __builtin_amdgcn_sched_barrier(0);
        tr_store<MAP, HASG, PERMW>(K, N, WT, scr, it, lane, gk);
        if (nx >= nitems) break;
        it = nx;
    }
}

template <bool F32OUT>
__device__ __forceinline__ void rms_row(const float* xrow, const float* g, void* orow, int lane) {
    const f32x4* xr = (const f32x4*)xrow + lane;
    f32x4 v[8]; float s = 0.f;
#pragma unroll
    for (int j = 0; j < 8; ++j) { v[j] = xr[64 * j]; s += (v[j].x * v[j].x + v[j].y * v[j].y) + (v[j].z * v[j].z + v[j].w * v[j].w); }
    const float rstd = 1.0f / sqrtf(wave_sum(s) * (1.0f / D) + 1e-6f);
    const f32x4* gr = (const f32x4*)g + lane;
#pragma unroll
    for (int j = 0; j < 8; ++j) {
        const f32x4 gg = gr[64 * j];
        const f32x4 o = v[j] * rstd * gg;
        if (F32OUT) ((f32x4*)orow)[lane + 64 * j] = o;
        else { u32x2 w; w.x = pk2(o.x, o.y); w.y = pk2(o.z, o.w); ((u32x2*)orow)[lane + 64 * j] = w; }
    }
}

constexpr int MB_K = 0, MB_KS = 272, MB_V = 34816, MB_VS = 320, MB_BUF = 75776, MB_KM = 75776, MB_G = 83968, MB_SEL = 92160, MB_ML = 65536, MB_OB = 0;
__device__ __forceinline__ void moba_item(const Params& p, LAS unsigned char* lds, int b, int h, int qb, int half) {
    unsigned char* wsb = opq_ptr(p.ws);
    const bf16_t* PROJ = (const bf16_t*)(wsb + WS_PROJ);
    const float* KMP = (const float*)(wsb + WS_KMP);
    bf16_t* Y = (bf16_t*)(wsb + WS_Y);
    const int tid = otid(), wave = __builtin_amdgcn_readfirstlane(tid >> 6), lane = tid & 63, r = lane & 31, hh = lane >> 5;
    const int wq = wave & 3, team = wave >> 2;
    const int q4 = (lane & 15) >> 2, p4 = lane & 3, b16 = (lane >> 4) & 1;
    const size_t tok0 = (size_t)b * S + qb * 256 + half * 128;
    LAS unsigned char* Kl = lds + MB_K; LAS unsigned char* Vl = lds + MB_V;
    LAS float* KM = (LAS float*)(lds + MB_KM); LAS float* G = (LAS float*)(lds + MB_G); LAS unsigned* SEL = (LAS unsigned*)(lds + MB_SEL);
    LAS float* ML = (LAS float*)(lds + MB_ML); LAS float* OB = (LAS float*)(lds + MB_OB);
    __syncthreads();
    unsigned mymask;
    if (qb > 3) {
        { const int j = tid >> 5, d = (tid & 31) * 4;
          if (j < qb) { const size_t o = ((size_t)(b * 16 + j)) * 1024 + h * 128 + d;
              const f32x4 a = *(const f32x4*)(KMP + o), c = *(const f32x4*)(KMP + 32 * 1024 + o);
              *(LAS f32x4*)(KM + j * 128 + d) = a + c; } }
        __syncthreads();
        { const int qi = tid >> 2, part = tid & 3;
          const u32x4* qp = (const u32x4*)(PROJ + (tok0 + qi) * INW + C_QA + h * 128 + part * 32);
          float qv[32];
#pragma unroll
          for (int c = 0; c < 4; ++c) { const u32x4 t = qp[c];
              qv[8 * c + 0] = bflo(t.x); qv[8 * c + 1] = bfhi(t.x); qv[8 * c + 2] = bflo(t.y); qv[8 * c + 3] = bfhi(t.y);
              qv[8 * c + 4] = bflo(t.z); qv[8 * c + 5] = bfhi(t.z); qv[8 * c + 6] = bflo(t.w); qv[8 * c + 7] = bfhi(t.w); }
          for (int j = 0; j < qb; ++j) {
              const LAS f32x4* km = (const LAS f32x4*)(KM + j * 128 + part * 32);
              float s = 0.f;
#pragma unroll
              for (int c = 0; c < 8; ++c) { const f32x4 k4 = km[c]; s += qv[4 * c] * k4.x + qv[4 * c + 1] * k4.y + qv[4 * c + 2] * k4.z + qv[4 * c + 3] * k4.w; }
              s += __shfl_xor(s, 1); s += __shfl_xor(s, 2);
              if (part == 0) G[qi * 16 + j] = s;
          } }
        __syncthreads();
        if (tid < 128) {
            unsigned mask = 0;
            for (int t = 0; t < 3; ++t) {
                float best = -INFINITY; int bi = 0;
                for (int j = 0; j < qb; ++j) { const float g = G[tid * 16 + j]; const bool ok = !((mask >> j) & 1u) && (g > best); if (ok) { best = g; bi = j; } }
                mask |= 1u << bi;
            }
            SEL[tid] = mask;
        }
        __syncthreads();
        mymask = SEL[32 * wq + r];
    } else mymask = (1u << qb) - 1u;

    bf16x8 qf[8];
    { const bf16_t* qrow = PROJ + (tok0 + 32 * wq + r) * INW + C_QA + h * 128 + 8 * hh;
#pragma unroll
      for (int ks = 0; ks < 8; ++ks) qf[ks] = *(const bf16x8*)(qrow + 16 * ks); }
    f32x16 O[4];
#pragma unroll
    for (int dt = 0; dt < 4; ++dt)
#pragma unroll
        for (int i = 0; i < 16; ++i) O[dt][i] = 0.f;
    float m_run = -1e30f, l_run = 0.f;
    const int nsteps = 2 * (qb + 1);
    const int qloc = 128 * half + 32 * wq + r;
    const float SC = 0.08838834764831845f * 1.4426950408889634f;
    u32x4 kreg[4], vreg[4];
    const int srow = tid >> 4, scol = tid & 15;
#define MOBA_ISSUE_K(step_) do { const int jj_ = (step_) >> 1, blk_ = jj_ == 0 ? qb : jj_ - 1; const int key0_ = blk_ * 256 + ((step_) & 1) * 128; \
        _Pragma("unroll") for (int i_ = 0; i_ < 4; ++i_) { const bf16_t* src_ = PROJ + ((size_t)b * S + key0_ + srow + 32 * i_) * INW + h * 128 + scol * 8; \
            kreg[i_] = *(const u32x4*)(src_ + C_KA); } } while (0)
#define MOBA_ISSUE_V(step_) do { const int jj_ = (step_) >> 1, blk_ = jj_ == 0 ? qb : jj_ - 1; const int key0_ = blk_ * 256 + ((step_) & 1) * 128; \
        _Pragma("unroll") for (int i_ = 0; i_ < 4; ++i_) { const bf16_t* src_ = PROJ + ((size_t)b * S + key0_ + srow + 32 * i_) * INW + h * 128 + scol * 8; \
            vreg[i_] = *(const u32x4*)(src_ + C_VA); } } while (0)
    MOBA_ISSUE_K(0); MOBA_ISSUE_V(0);
#pragma unroll
    for (int i = 0; i < 4; ++i) { *(LAS u32x4*)(Kl + (srow + 32 * i) * MB_KS + scol * 16) = kreg[i]; *(LAS u32x4*)(Vl + (srow + 32 * i) * MB_VS + scol * 16) = vreg[i]; }
    if (nsteps > 1) { MOBA_ISSUE_K(1); MOBA_ISSUE_V(1); }
    for (int step = 0; step < nsteps; ++step) {
        __syncthreads();
        const int cb = (step & 1) * MB_BUF;
        if (step + 1 < nsteps) {
            const int nb = MB_BUF - cb;
#pragma unroll
            for (int i = 0; i < 4; ++i) { *(LAS u32x4*)(Kl + nb + (srow + 32 * i) * MB_KS + scol * 16) = kreg[i]; *(LAS u32x4*)(Vl + nb + (srow + 32 * i) * MB_VS + scol * 16) = vreg[i]; }
            if (step + 2 < nsteps) { MOBA_ISSUE_K(step + 2); MOBA_ISSUE_V(step + 2); }
        }
        const int jj = step >> 1, blk = jj == 0 ? qb : jj - 1;
        const bool own = jj == 0;
        const bool sel = own || ((mymask >> blk) & 1u);
        f32x16 s[2];
#pragma unroll
        for (int kt = 0; kt < 2; ++kt) {
            bf16x8 af[8];
#pragma unroll
            for (int ks = 0; ks < 8; ++ks) af[ks] = *(const LAS bf16x8*)(Kl + cb + (64 * team + 32 * kt + r) * MB_KS + (16 * ks + 8 * hh) * 2);
            __builtin_amdgcn_sched_barrier(0);
#pragma unroll
            for (int i = 0; i < 16; ++i) s[kt][i] = 0.f;
#pragma unroll
            for (int ks = 0; ks < 8; ++ks) s[kt] = MFMA32(af[ks], qf[ks], s[kt]);
            __builtin_amdgcn_sched_barrier(0);
        }
        float tmax = -INFINITY;
        const int kbase = (step & 1) * 128 + 64 * team;
        if (own) {
            asm volatile("" ::: "memory");
#pragma unroll
            for (int kt = 0; kt < 2; ++kt)
#pragma unroll
                for (int i = 0; i < 16; ++i) {
                    const int kl = kbase + 32 * kt + crow(i, hh);
                    const float v = (kl <= qloc) ? s[kt][i] : -INFINITY;
                    s[kt][i] = v; tmax = fmaxf(tmax, v);
                }
        } else {
            asm volatile("" ::: "memory");
#pragma unroll
            for (int kt = 0; kt < 2; ++kt)
#pragma unroll
                for (int i = 0; i < 16; ++i) tmax = fmaxf(tmax, s[kt][i]);
            tmax = sel ? tmax : -INFINITY;
        }
        tmax = fmaxf(tmax, __shfl_xor(tmax, 32)) * SC;
        const float m_new = fmaxf(m_run, tmax);
        const float alpha = __builtin_amdgcn_exp2f(m_run - m_new);
        const float msub = sel ? m_new : INFINITY;
        float psum = 0.f;
#pragma unroll
        for (int kt = 0; kt < 2; ++kt)
#pragma unroll
            for (int i = 0; i < 16; ++i) { const float pv = __builtin_amdgcn_exp2f(__builtin_fmaf(s[kt][i], SC, -msub)); s[kt][i] = pv; psum += pv; }
        psum += __shfl_xor(psum, 32);
        l_run = l_run * alpha + psum; m_run = m_new;
        {
#pragma unroll
            for (int dt = 0; dt < 4; ++dt)
#pragma unroll
                for (int i = 0; i < 16; ++i) O[dt][i] *= alpha;
        }
#pragma unroll
        for (int kt = 0; kt < 2; ++kt) {
            bf16x8 vf0[4], vf1[4];
#pragma unroll
            for (int dt = 0; dt < 4; ++dt) {
                vf0[dt] = tr_read2(Vl + cb + (64 * team + 32 * kt + 4 * hh + q4) * MB_VS + (32 * dt + 16 * b16 + 4 * p4) * 2, 8 * MB_VS);
                vf1[dt] = tr_read2(Vl + cb + (64 * team + 32 * kt + 16 + 4 * hh + q4) * MB_VS + (32 * dt + 16 * b16 + 4 * p4) * 2, 8 * MB_VS);
            }
            const bf16x8 pf0 = pack_step<0>(s[kt]), pf1 = pack_step<1>(s[kt]);
            __builtin_amdgcn_sched_barrier(0);
#pragma unroll
            for (int dt = 0; dt < 4; ++dt) O[dt] = MFMA32(vf0[dt], pf0, O[dt]);
#pragma unroll
            for (int dt = 0; dt < 4; ++dt) O[dt] = MFMA32(vf1[dt], pf1, O[dt]);
            __builtin_amdgcn_sched_barrier(0);
        }
    }
#undef MOBA_ISSUE_K
#undef MOBA_ISSUE_V
    __syncthreads();
    if (team == 1) {
#pragma unroll
        for (int dt = 0; dt < 4; ++dt)
#pragma unroll
            for (int i = 0; i < 16; ++i) OB[((wq * 4 + dt) * 16 + i) * 64 + lane] = O[dt][i];
        ML[(wq * 64 + lane) * 2] = m_run; ML[(wq * 64 + lane) * 2 + 1] = l_run;
    }
    __syncthreads();
    if (team == 0) {
        const float mB = ML[(wq * 64 + lane) * 2], lB = ML[(wq * 64 + lane) * 2 + 1];
        const float mm = fmaxf(m_run, mB), a = __builtin_amdgcn_exp2f(m_run - mm), bsc = __builtin_amdgcn_exp2f(mB - mm);
        const float inv = 1.0f / (l_run * a + lB * bsc);
        const float a2 = a * inv, b2 = bsc * inv;
        bf16_t* yrow = Y + (tok0 + 32 * wq + r) * 1024 + h * 128 + 4 * hh;
#pragma unroll
        for (int dt = 0; dt < 4; ++dt)
#pragma unroll
            for (int g4 = 0; g4 < 4; ++g4) {
                float o[4];
#pragma unroll
                for (int e = 0; e < 4; ++e) o[e] = O[dt][4 * g4 + e] * a2 + OB[((wq * 4 + dt) * 16 + 4 * g4 + e) * 64 + lane] * b2;
                u32x2 w; w.x = pk2(o[0], o[1]); w.y = pk2(o[2], o[3]);
                *(u32x2*)((char*)Y + tiled_off((int)(tok0 + 32 * wq + r), h * 128 + 4 * hh + 32 * dt + 8 * g4, 1024 / 64)) = w;
            }
    }
}

__device__ __forceinline__ float ret_log2g(int h) { const double g = 1.0 - ldexp(1.0, -(5 + h)); return (float)log2(g); }
constexpr int RK_K = 0, RK_KS = 320, RK_V = 40960, RK_VS = 576;
__device__ __forceinline__ void ret_kv_item(const Params& p, LAS unsigned char* lds, int b, int h, int n) {
    unsigned char* wsb = opq_ptr(p.ws);
    const bf16_t* PROJ = (const bf16_t*)(wsb + WS_PROJ);
    float* KV = (float*)(wsb + WS_HID);
    const int tid = otid(), wave = __builtin_amdgcn_readfirstlane(tid >> 6), lane = tid & 63, r = lane & 31, hh = lane >> 5;
    const int q4 = (lane & 15) >> 2, p4 = lane & 3, b16 = (lane >> 4) & 1;
    const size_t tok0 = (size_t)b * S + n * 128;
    const float lg2 = ret_log2g(h);
    LAS unsigned char* Kl = lds + RK_K; LAS unsigned char* Vl = lds + RK_V;
    __syncthreads();
    u32x4 kin[4], vin[8];
#pragma unroll
    for (int i = 0; i < 4; ++i) { const int c = tid + 512 * i, row = c >> 4, cc = c & 15; kin[i] = *(const u32x4*)(PROJ + (tok0 + row) * INW + C_KR + h * 128 + cc * 8); }
#pragma unroll
    for (int i = 0; i < 8; ++i) { const int c = tid + 512 * i, row = c >> 5, cc = c & 31; vin[i] = *(const u32x4*)(PROJ + (tok0 + row) * INW + C_VR + h * 256 + cc * 8); }
    __builtin_amdgcn_sched_barrier(0);
#pragma unroll
    for (int i = 0; i < 4; ++i) {
        const int c = tid + 512 * i, row = c >> 4, cc = c & 15;
        const u32x4 t = kin[i];
        const float z = __builtin_amdgcn_exp2f((float)(127 - row) * lg2);
        u32x4 o; o.x = pk2(bflo(t.x) * z, bfhi(t.x) * z); o.y = pk2(bflo(t.y) * z, bfhi(t.y) * z); o.z = pk2(bflo(t.z) * z, bfhi(t.z) * z); o.w = pk2(bflo(t.w) * z, bfhi(t.w) * z);
        *(LAS u32x4*)(Kl + row * RK_KS + cc * 16) = o;
    }
#pragma unroll
    for (int i = 0; i < 8; ++i) {
        const int c = tid + 512 * i, row = c >> 5, cc = c & 31;
        *(LAS u32x4*)(Vl + row * RK_VS + cc * 16) = vin[i];
    }
    __syncthreads();
    f32x16 acc[4];
#pragma unroll
    for (int dt = 0; dt < 4; ++dt)
#pragma unroll
        for (int i = 0; i < 16; ++i) acc[dt][i] = 0.f;
#pragma unroll
    for (int ks = 0; ks < 8; ++ks) {
        const int m0 = 16 * ks + 8 * hh + q4;
        const bf16x8 af = tr_read2(Vl + m0 * RK_VS + (32 * wave + 16 * b16 + 4 * p4) * 2, 4 * RK_VS);
        bf16x8 bfr[4];
#pragma unroll
        for (int dt = 0; dt < 4; ++dt) bfr[dt] = tr_read2(Kl + m0 * RK_KS + (32 * dt + 16 * b16 + 4 * p4) * 2, 4 * RK_KS);
        if (ks & 1) __builtin_amdgcn_sched_barrier(0);
#pragma unroll
        for (int dt = 0; dt < 4; ++dt) acc[dt] = MFMA32(af, bfr[dt], acc[dt]);
    }
    float* kvp = KV + ((size_t)((b * 8 + h) * 32 + n)) * (256 * 128);
#pragma unroll
    for (int dt = 0; dt < 4; ++dt)
#pragma unroll
        for (int i = 0; i < 16; ++i) kvp[(32 * wave + crow(i, hh)) * 128 + 32 * dt + r] = acc[dt][i];
}

constexpr int RO_K = 0, RO_KS = 272, RO_V = 34816, RO_VS = 576, RO_STAT = 108544;
__device__ __forceinline__ void ret_out_item(const Params& p, LAS unsigned char* lds, int b, int h, int n) {
    unsigned char* wsb = opq_ptr(p.ws);
    const bf16_t* PROJ = (const bf16_t*)(wsb + WS_PROJ);
    const bf16_t* PREVT = (const bf16_t*)(wsb + WS_XN);
    bf16_t* Y = (bf16_t*)(wsb + WS_YR);
    const int tid = otid(), wave = __builtin_amdgcn_readfirstlane(tid >> 6), lane = tid & 63, r = lane & 31, hh = lane >> 5;
    const int q4 = (lane & 15) >> 2, p4 = lane & 3, b16 = (lane >> 4) & 1;
    const int cq = wave & 3, eh = wave >> 2;
    const size_t tok0 = (size_t)b * S + n * 128;
    const float lg2 = ret_log2g(h);
    LAS unsigned char* Kl = lds + RO_K; LAS unsigned char* Vl = lds + RO_V; LAS float* STAT = (LAS float*)(lds + RO_STAT);
    __syncthreads();
    bf16x8 qf[8];
    { const bf16_t* qrow = PROJ + (tok0 + 32 * cq + r) * INW + C_QR + h * 128 + 8 * hh;
#pragma unroll
      for (int ks = 0; ks < 8; ++ks) qf[ks] = *(const bf16x8*)(qrow + 16 * ks); }
    bf16x8 pfr[4][8];
    { const bf16_t* pv = PREVT + ((size_t)((b * 8 + h) * 32 + n)) * (256 * 128) + (size_t)(eh * 32 * 64 + lane) * 8;
#pragma unroll
      for (int et = 0; et < 4; ++et)
#pragma unroll
          for (int ks = 0; ks < 8; ++ks) pfr[et][ks] = *(const bf16x8*)(pv + (size_t)((et * 8 + ks) * 64) * 8); }
    { u32x4 kin[4], vin[4];
#pragma unroll
      for (int i = 0; i < 4; ++i) { const int c = tid + 512 * i, row = c >> 4, cc = c & 15; kin[i] = *(const u32x4*)(PROJ + (tok0 + row) * INW + C_KR + h * 128 + cc * 8); }
#pragma unroll
      for (int i = 0; i < 4; ++i) { const int c = tid + 512 * i, row = c >> 5, cc = c & 31; vin[i] = *(const u32x4*)(PROJ + (tok0 + row) * INW + C_VR + h * 256 + cc * 8); }
      __builtin_amdgcn_sched_barrier(0);
#pragma unroll
      for (int i = 0; i < 4; ++i) { const int c = tid + 512 * i, row = c >> 4, cc = c & 15; *(LAS u32x4*)(Kl + row * RO_KS + cc * 16) = kin[i]; }
#pragma unroll
      for (int i = 0; i < 4; ++i) { const int c = tid + 512 * i, row = c >> 5, cc = c & 31; *(LAS u32x4*)(Vl + row * RO_VS + cc * 16) = vin[i]; }
      __builtin_amdgcn_sched_barrier(0);
#pragma unroll
      for (int i = 0; i < 4; ++i) { const int c = tid + 512 * (i + 4), row = c >> 5, cc = c & 31; vin[i] = *(const u32x4*)(PROJ + (tok0 + row) * INW + C_VR + h * 256 + cc * 8); }
      __builtin_amdgcn_sched_barrier(0);
#pragma unroll
      for (int i = 0; i < 4; ++i) { const int c = tid + 512 * (i + 4), row = c >> 5, cc = c & 31; *(LAS u32x4*)(Vl + row * RO_VS + cc * 16) = vin[i]; }
    }
    f32x16 acc[4];
#pragma unroll
    for (int et = 0; et < 4; ++et)
#pragma unroll
        for (int i = 0; i < 16; ++i) acc[et][i] = 0.f;
#pragma unroll
    for (int et = 0; et < 4; ++et)
#pragma unroll
        for (int ks = 0; ks < 8; ++ks) acc[et] = MFMA32(pfr[et][ks], qf[ks], acc[et]);
    const int cloc = 32 * cq + r;
    { const float xi = __builtin_amdgcn_exp2f((float)(cloc + 1) * lg2);
#pragma unroll
      for (int et = 0; et < 4; ++et)
#pragma unroll
          for (int i = 0; i < 16; ++i) acc[et][i] *= xi; }
    __syncthreads();
    for (int kt = 0; kt <= cq; ++kt) {
        f32x16 s;
#pragma unroll
        for (int i = 0; i < 16; ++i) s[i] = 0.f;
        { bf16x8 af[8];
#pragma unroll
          for (int ks = 0; ks < 8; ++ks) af[ks] = *(const LAS bf16x8*)(Kl + (32 * kt + r) * RO_KS + (16 * ks + 8 * hh) * 2);
          __builtin_amdgcn_sched_barrier(0);
#pragma unroll
          for (int ks = 0; ks < 8; ++ks) s = MFMA32(af[ks], qf[ks], s);
          __builtin_amdgcn_sched_barrier(0); }
#pragma unroll
        for (int i = 0; i < 16; ++i) {
            const int diff = cloc - (32 * kt + crow(i, hh));
            s[i] = diff >= 0 ? s[i] * __builtin_amdgcn_exp2f((float)diff * lg2) : 0.f;
        }
        { bf16x8 vf0[4], vf1[4];
#pragma unroll
          for (int et = 0; et < 4; ++et) {
              vf0[et] = tr_read2(Vl + (32 * kt + 4 * hh + q4) * RO_VS + (128 * eh + 32 * et + 16 * b16 + 4 * p4) * 2, 8 * RO_VS);
              vf1[et] = tr_read2(Vl + (32 * kt + 16 + 4 * hh + q4) * RO_VS + (128 * eh + 32 * et + 16 * b16 + 4 * p4) * 2, 8 * RO_VS); }
          const bf16x8 pf0 = pack_step<0>(s), pf1 = pack_step<1>(s);
          __builtin_amdgcn_sched_barrier(0);
#pragma unroll
          for (int et = 0; et < 4; ++et) acc[et] = MFMA32(vf0[et], pf0, acc[et]);
#pragma unroll
          for (int et = 0; et < 4; ++et) acc[et] = MFMA32(vf1[et], pf1, acc[et]);
          __builtin_amdgcn_sched_barrier(0); }
    }
    float sm = 0.f, sq = 0.f;
#pragma unroll
    for (int et = 0; et < 4; ++et)
#pragma unroll
        for (int i = 0; i < 16; ++i) { sm += acc[et][i]; sq += acc[et][i] * acc[et][i]; }
    sm += __shfl_xor(sm, 32); sq += __shfl_xor(sq, 32);
    if (hh == 0) { STAT[(eh * 128 + cloc) * 2] = sm; STAT[(eh * 128 + cloc) * 2 + 1] = sq; }
    __syncthreads();
    { const float osm = STAT[((eh ^ 1) * 128 + cloc) * 2], osq = STAT[((eh ^ 1) * 128 + cloc) * 2 + 1];
      sm += osm; sq += osq; }
    const float mu = sm * (1.0f / 256.0f);
    const float var = fmaxf(sq * (1.0f / 256.0f) - mu * mu, 0.f);
    const float rstd = 1.0f / sqrtf(var + 1e-6f);
    const size_t tok = tok0 + cloc;
    const bf16_t* grow = (const bf16_t*)(wsb + WS_GRL) + ((size_t)((b * 8 + h) * 32 + n)) * 32768 + (size_t)(((eh * 16 * 4 + cq) * 2 + hh) * 32 + r) * 4;
    bf16_t* yrow = Y + tok * 2048 + h * 256 + 128 * eh + 4 * hh;
    u32x2 gq[4][4];
#pragma unroll
    for (int et = 0; et < 4; ++et)
#pragma unroll
        for (int g4 = 0; g4 < 4; ++g4) gq[et][g4] = *(const u32x2*)(grow + (size_t)((et * 4 + g4) * 4 * 2 * 32 * 4));
    __builtin_amdgcn_sched_barrier(0);
#pragma unroll
    for (int et = 0; et < 4; ++et)
#pragma unroll
        for (int g4 = 0; g4 < 4; ++g4) {
            const u32x2 g = gq[et][g4];
            const float o0 = (acc[et][4 * g4 + 0] - mu) * rstd * siluf_(bflo(g.x));
            const float o1 = (acc[et][4 * g4 + 1] - mu) * rstd * siluf_(bfhi(g.x));
            const float o2 = (acc[et][4 * g4 + 2] - mu) * rstd * siluf_(bflo(g.y));
            const float o3 = (acc[et][4 * g4 + 3] - mu) * rstd * siluf_(bfhi(g.y));
            u32x2 w; w.x = pk2(o0, o1); w.y = pk2(o2, o3);
            *(u32x2*)((char*)Y + tiled_off((int)tok, h * 256 + 128 * eh + 4 * hh + 32 * et + 8 * g4, 2048 / 64)) = w;
        }
}

__global__ void __launch_bounds__(512, 2) mega_fwd(Params p) {
    extern __shared__ __attribute__((aligned(16))) unsigned char smem[];
    LAS unsigned char* lds = (LAS unsigned char*)smem;
    cg::grid_group grid = cg::this_grid();
#define PHASE_IDS const int tid = otid(), wave = __builtin_amdgcn_readfirstlane(tid >> 6), lane = tid & 63, gw = blockIdx.x * 8 + wave; (void)lane; (void)gw
#define PHASE_ENV unsigned char* ws = opq_ptr(p.ws); const int G = opq_int((int)gridDim.x), ngw = G * 8; (void)ws; (void)ngw
#define P_X ((float*)(ws + WS_X))
#define P_XB ((bf16_t*)(ws + WS_XB))
#define P_SS ((float*)(ws + WS_SS))
#define P_HID ((bf16_t*)(ws + WS_HID))
#define P_PROJ ((bf16_t*)(ws + WS_PROJ))
#define P_Y ((bf16_t*)(ws + WS_Y))
#define P_YR ((bf16_t*)(ws + WS_YR))
#define P_KMP ((float*)(ws + WS_KMP))
#define P_ROPE ((float*)(ws + WS_ROPE))
#define P_T1 ((float*)(ws + WS_HID))
#define P_KV ((float*)(ws + WS_HID))
#define P_PREVT ((bf16_t*)(ws + WS_XN))
#define P_MG ((bf16_t*)(ws + WS_XN))
#define P_W(off) ((bf16_t*)(ws + (off)))
    { volatile LAS unsigned* st0 = (volatile LAS unsigned*)(lds + LDS_BYTES - 16);
      if (threadIdx.x < 4) st0[threadIdx.x] = 0u;
      __syncthreads(); }
    xcd_barrier_post((unsigned*)(p.ws + WS_CTL));
    int nsync = 0;
#define GSYNC do { xcd_barrier(p.ws, (volatile LAS unsigned*)(lds + LDS_BYTES - 16)); ++nsync; } while (0)
    if (p.out == nullptr) grid.sync();

    { PHASE_IDS; PHASE_ENV;
    float* ROPE = P_ROPE;
    for (int idx = blockIdx.x * 512 + tid; idx < 2 * 4096 * 64; idx += G * 512) {
        const int kind = idx >> 18, pos = (idx >> 6) & 4095, i = idx & 63;
        const double ex = kind ? (double)i / 63.0 : (double)i / 64.0;
        const float invf = (float)exp(-ex * 9.210340371976184);
        const float ang = (float)pos * invf;
        const double rev = (double)ang * 0.15915494309189535;
        const float fr = (float)(rev - floor(rev));
        ROPE[(kind * 2 + 0) * (4096 * 64) + pos * 64 + i] = __builtin_amdgcn_cosf(fr);
        ROPE[(kind * 2 + 1) * (4096 * 64) + pos * 64 + i] = __builtin_amdgcn_sinf(fr);
    } }

    for (int l = 0; l < DEPTH; ++l) {
        {
            PHASE_IDS; PHASE_ENV;
            LAS float* scr = (LAS float*)(lds + wave * 8448);
            transpose_mat<1, true, true>(p.in[2] + (size_t)l * D * DFF, D, DFF, P_W(WS_WGU1), scr, gw, ngw, lane, p.in[1] + l * D);
            transpose_mat<2, true, true>(p.in[3] + (size_t)l * D * DFF, D, DFF, P_W(WS_WGU1), scr, gw, ngw, lane, p.in[1] + l * D);
            transpose_mat<0>(p.in[4] + (size_t)l * DFF * D, DFF, D, P_W(WS_WD1), scr, gw, ngw, lane);
            transpose_mat<3, true, true>(p.in[6] + (size_t)l * D * INW, D, INW, P_W(WS_WIN), scr, gw, ngw, lane, p.in[5] + l * D);
            transpose_mat<0, false, true>(p.in[7] + (size_t)l * 1024 * D, 1024, D, P_W(WS_WA), scr, gw, ngw, lane);
            transpose_mat<0, false, true>(p.in[8] + (size_t)l * 2048 * D, 2048, D, P_W(WS_WB), scr, gw, ngw, lane);
            transpose_mat<0>(p.in[9] + (size_t)l * D * D, D, D, P_W(WS_WO), scr, gw, ngw, lane);
            transpose_mat<1, true, true>(p.in[11] + (size_t)l * D * DFF, D, DFF, P_W(WS_WGU2), scr, gw, ngw, lane, p.in[10] + l * D);
            transpose_mat<2, true, true>(p.in[12] + (size_t)l * D * DFF, D, DFF, P_W(WS_WGU2), scr, gw, ngw, lane, p.in[10] + l * D);
            transpose_mat<0>(p.in[13] + (size_t)l * DFF * D, DFF, D, P_W(WS_WD2), scr, gw, ngw, lane);
            if (l == 0) {
                float* SSB = P_SS; bf16_t* XB = P_XB; const float* xin = p.in[0];
                for (int m = gw; m < M; m += ngw) {
                    const f32x4* xr = (const f32x4*)(xin + (size_t)m * D) + lane; float sq = 0.f;
                    f32x4 xv8[8];
#pragma unroll
                    for (int j = 0; j < 8; ++j) xv8[j] = xr[64 * j];
                    __builtin_amdgcn_sched_barrier(0);
#pragma unroll
                    for (int j = 0; j < 8; ++j) { const f32x4 v = xv8[j]; sq += (v.x * v.x + v.y * v.y) + (v.z * v.z + v.w * v.w);
                        u32x2 w; w.x = pk2(v.x, v.y); w.y = pk2(v.z, v.w); *(u32x2*)((char*)XB + tiled_off(m, 4 * (lane + 64 * j), D / 64)) = w; }
                    sq = wave_sum(sq);
                    if (lane < 8) SSB[(size_t)lane * M + m] = (lane == 0) ? sq : 0.f;
                }
            }
        }
        GSYNC;
        { PHASE_ENV; pg8::StaticOrder SO; pg8::Gemm g{P_XB, P_W(WS_WGU1), M, 2 * DFF, D}; SO.init(M, 2 * DFF, G, blockIdx.x); stage_row_ss(lds, P_SS + (size_t)(3 * l) * 8 * M, SO); EpiSwiGLU E{P_HID, (const LAS float*)(lds + LDS_RS)}; pg8::gemm_phase(lds, g, SO, E); }
        GSYNC;
        { PHASE_ENV; pg8::StaticOrder SO; pg8::Gemm g{P_HID, P_W(WS_WD1), M, D, DFF}; SO.init(M, D, G, blockIdx.x); EpiResidual E{(l == 0) ? p.in[0] : P_X, P_X, P_XB, P_SS + (size_t)(3 * l + 1) * 8 * M, (LAS float*)(lds + LDS_RS), 0.5f}; pg8::gemm_phase(lds, g, SO, E); }
        GSYNC;
        { PHASE_ENV; pg8::StaticOrder SO; pg8::Gemm g{P_XB, P_W(WS_WIN), M, INW, D}; SO.init(M, INW, G, blockIdx.x); stage_row_ss(lds, P_SS + (size_t)(3 * l + 1) * 8 * M, SO); EpiProj E{P_PROJ, P_KMP, P_ROPE, (const LAS float*)(lds + LDS_RS), (bf16_t*)(ws + WS_GRL)}; pg8::gemm_phase(lds, g, SO, E); }
        GSYNC;
        { PHASE_ENV;
        for (int pair = blockIdx.x; pair < 256; pair += G) {
            const int bh = pair >> 4, q16 = pair & 15;
            moba_item(p, lds, bh >> 3, bh & 7, q16, 0);
            moba_item(p, lds, bh >> 3, bh & 7, 15 - q16, 1);
        }
        for (int it = blockIdx.x; it < 512; it += G) ret_kv_item(p, lds, it >> 8, (it >> 5) & 7, it & 31);
        }
        GSYNC;
        { PHASE_IDS; PHASE_ENV;
        for (int idx = blockIdx.x * 512 + tid; idx < 16 * 32768; idx += G * 512) {
            const int bh = idx >> 15, ed = idx & 32767, h = bh & 7;
            const float decay = __builtin_amdgcn_exp2f(128.0f * ret_log2g(h));
            const float* kv = P_KV + (size_t)bh * 32 * 32768 + ed;
            const int e_ = ed >> 7, d_ = ed & 127;
            const int foff = ((((e_ >> 7) * 4 + ((e_ >> 5) & 3)) * 8 + (d_ >> 4)) * 64 + ((d_ >> 3) & 1) * 32 + (e_ & 31)) * 8 + (d_ & 7);
            bf16_t* pt = P_PREVT + (size_t)bh * 32 * 32768 + foff;
            float kvv[32];
#pragma unroll
            for (int n = 0; n < 32; ++n) kvv[n] = kv[(size_t)n * 32768];
            float st = 0.f;
#pragma unroll
            for (int n = 0; n < 32; ++n) {
                pt[(size_t)n * 32768] = (bf16_t)(pk2(st, 0.f) & 0xffffu);
                st = decay * st + kvv[n];
            }
        } }
        GSYNC;
        { PHASE_ENV;
        for (int it = blockIdx.x; it < 512; it += G) ret_out_item(p, lds, it >> 8, (it >> 5) & 7, it & 31);
        }
        GSYNC;
        { PHASE_ENV; pg8::StaticOrder SO; pg8::Gemm g{P_YR, P_W(WS_WB), M, D, 2048}; SO.init(M, D, G, blockIdx.x); EpiBranchB E{P_T1, P_PROJ}; pg8::gemm_phase(lds, g, SO, E); }
        { PHASE_ENV; pg8::StaticOrder SO; pg8::Gemm g{P_Y, P_W(WS_WA), M, D, 1024}; SO.init(M, D, G, blockIdx.x); EpiBranchA E{P_T1, P_PROJ, P_MG}; pg8::gemm_phase(lds, g, SO, E); }
        GSYNC;
        { PHASE_ENV; pg8::StaticOrder SO; pg8::Gemm g{P_MG, P_W(WS_WO), M, D, D}; SO.init(M, D, G, blockIdx.x); EpiResidual E{P_X, P_X, P_XB, P_SS + (size_t)(3 * l + 2) * 8 * M, (LAS float*)(lds + LDS_RS), 1.0f}; pg8::gemm_phase(lds, g, SO, E); }
        GSYNC;
        { PHASE_ENV; pg8::StaticOrder SO; pg8::Gemm g{P_XB, P_W(WS_WGU2), M, 2 * DFF, D}; SO.init(M, 2 * DFF, G, blockIdx.x); stage_row_ss(lds, P_SS + (size_t)(3 * l + 2) * 8 * M, SO); EpiSwiGLU E{P_HID, (const LAS float*)(lds + LDS_RS)}; pg8::gemm_phase(lds, g, SO, E); }
        GSYNC;
        { PHASE_ENV; pg8::StaticOrder SO; pg8::Gemm g{P_HID, P_W(WS_WD2), M, D, DFF}; SO.init(M, D, G, blockIdx.x); EpiResidual E{P_X, P_X, P_XB, P_SS + (size_t)(3 * l + 3) * 8 * M, (LAS float*)(lds + LDS_RS), 0.5f}; pg8::gemm_phase(lds, g, SO, E); }
        GSYNC;
    }
    { PHASE_IDS; PHASE_ENV;
    for (int m = gw; m < M; m += ngw) rms_row<true>(P_X + (size_t)m * D, p.in[14], p.out + (size_t)m * D, lane); }
}

extern "C" void kernel_launch(void* const* d_in, const int* in_sizes, int n_in, void* d_out, int out_size, void* d_ws, size_t ws_size, hipStream_t stream) {
    static int grid = 0;
    if (grid == 0) {
        if (n_in != 15 || ws_size < WS_END) { fprintf(stderr, "kernel_launch: n_in %d ws %zu need %zu\n", n_in, ws_size, (size_t)WS_END); grid = -1; return; }
        int dev = 0, cus = 0, per_cu = 0;
        hipGetDevice(&dev);
        hipDeviceGetAttribute(&cus, hipDeviceAttributeMultiprocessorCount, dev);
        hipFuncSetAttribute((const void*)mega_fwd, hipFuncAttributeMaxDynamicSharedMemorySize, LDS_BYTES);
        hipOccupancyMaxActiveBlocksPerMultiprocessor(&per_cu, (const void*)mega_fwd, 512, LDS_BYTES);
        if (per_cu < 1) { fprintf(stderr, "kernel_launch: occupancy query says %d blocks per CU\n", per_cu); per_cu = 1; }
        (void)hipGetLastError();
        grid = cus * per_cu;
        if (grid > 256) grid = 256;
    }
    if (grid < 0) return;
    if (hipMemsetAsync((char*)d_ws + WS_CTL, 0, CTL_BYTES, stream) != hipSuccess) { fprintf(stderr, "memset failed\n"); return; }
    Params p{};
    for (int i = 0; i < 15; ++i) p.in[i] = (const float*)d_in[i];
    p.out = (float*)d_out; p.ws = (unsigned char*)d_ws;
    void* args[] = {&p};
    hipError_t e = hipLaunchCooperativeKernel((const void*)mega_fwd, dim3(grid), dim3(512), args, LDS_BYTES, stream);
    if (e != hipSuccess) fprintf(stderr, "cooperative launch failed: %s (grid %d)\n", hipGetErrorString(e), grid);
}
```
